# Optimizing an MI355X kernel written in HIP

```python
import math
import jax
import jax.numpy as jnp
from jax import lax
import numpy as np

D_MODEL = 1024
BATCH = 4
SEQ = 4096
DEPTH = 2

GRID_W = 64
CTX_LEN = 256
HEAD_DIM = 64
ROPE_BASE = 10000.0
EPS = 1e-6
BLK = 128
A_HEADS = 8
A_KV_HEADS = 2
WINDOW = 128
SSM_HEADS = 16
SSM_HEADDIM = 64
SSM_INNER = SSM_HEADS * SSM_HEADDIM
SSM_GROUPS = 2
SSM_STATE = 128
SSM_CONV = 3
SSM_CHUNK = 128
SSM_BC = SSM_GROUPS * SSM_STATE
SSM_XBC = SSM_INNER + 2 * SSM_BC
C_HEADS = 8
C_KV_HEADS = 2
D_FF = 2816
FFN_CONV = 3
A_Q_W = A_HEADS * HEAD_DIM
A_KV_W = A_KV_HEADS * HEAD_DIM
C_Q_W = C_HEADS * HEAD_DIM
C_KV_W = C_KV_HEADS * HEAD_DIM
IN_WIDTH = (A_Q_W + 2 * A_KV_W) + (SSM_INNER + SSM_XBC + 2 * SSM_HEADS) + (C_Q_W + 2 * C_KV_W) + 3 * D_MODEL

kernel_name = 'hybrid_swa_ssd_gridattn_convffn_prefix'


def _in_spans():
    sizes = (('a_q', A_Q_W), ('a_k', A_KV_W), ('a_v', A_KV_W),
             ('b_z', SSM_INNER), ('b_xbc', SSM_XBC), ('b_dt', 2 * SSM_HEADS),
             ('c_q', C_Q_W), ('c_k', C_KV_W), ('c_v', C_KV_W),
             ('gates', 3 * D_MODEL))
    spans, start = {}, 0
    for name, n in sizes:
        spans[name] = (start, start + n)
        start += n
    return spans


def rms_norm(x, g):
    xf = x.astype(jnp.float32)
    y = xf * lax.rsqrt(jnp.mean(xf * xf, axis=-1, keepdims=True) + EPS)
    return (y * g.astype(jnp.float32)).astype(x.dtype)


def modulate(h, shift, scale):
    return h * (1 + scale) + shift


def grid_rope(rows):
    t_row = jnp.repeat(jnp.arange(rows), GRID_W).astype(jnp.float32)
    t_col = jnp.tile(jnp.arange(GRID_W), rows).astype(jnp.float32)
    n = HEAD_DIM // 4
    inv = ROPE_BASE ** (-jnp.arange(n, dtype=jnp.float32) / n)
    ang = jnp.concatenate([t_row[:, None] * inv, t_col[:, None] * inv], axis=-1)
    return jnp.cos(ang), jnp.sin(ang)


def apply_rope(x, cos, sin):
    b, L, h, dh = x.shape
    xr = x.astype(jnp.float32).reshape(b, L, h, dh // 2, 2)
    c = cos[None, :, None, :]
    s = sin[None, :, None, :]
    x1, x2 = xr[..., 0], xr[..., 1]
    out = jnp.stack([x1 * c - x2 * s, x1 * s + x2 * c], axis=-1)
    return out.reshape(b, L, h, dh).astype(x.dtype)


def dwconv(u, w, bias):
    k = w.shape[0]
    pad = k // 2
    y = lax.conv_general_dilated(u, w[:, None, :].astype(u.dtype), window_strides=(1,),
                                 padding=[(pad, pad)], dimension_numbers=('NWC', 'WIO', 'NWC'),
                                 feature_group_count=u.shape[-1])
    return y + bias.astype(u.dtype)


def dense_attention(q, k, v, sink):
    b, lq, hq, dh = q.shape
    hkv = k.shape[2]
    g = hq // hkv
    qg = q.reshape(b, lq, hkv, g, dh)
    s = jnp.einsum('bqhgd,bkhd->bhgqk', qg, k).astype(jnp.float32) * (dh ** -0.5)
    if sink is not None:
        s_sink = jnp.broadcast_to(sink.astype(jnp.float32).reshape(1, hkv, g, 1, 1), s.shape[:-1] + (1,))
        s = jnp.concatenate([s, s_sink], axis=-1)
    p = jax.nn.softmax(s, axis=-1)
    if sink is not None:
        p = p[..., :-1]
    o = jnp.einsum('bhgqk,bkhd->bqhgd', p.astype(v.dtype), v)
    return o.reshape(b, lq, hq * dh)


def window_attention(q, k, v, kc, vc, sink):
    b, L, hq, dh = q.shape
    hkv = k.shape[2]
    g = hq // hkv
    nb = L // BLK
    lc = kc.shape[1]
    qb = q.reshape(b, nb, BLK, hkv, g, dh)
    pad = ((0, 0), (BLK, BLK), (0, 0), (0, 0))
    kp = jnp.pad(k, pad).reshape(b, nb + 2, BLK, hkv, dh)
    vp = jnp.pad(v, pad).reshape(b, nb + 2, BLK, hkv, dh)
    kw = jnp.concatenate([kp[:, :-2], kp[:, 1:-1], kp[:, 2:]], axis=2)
    vw = jnp.concatenate([vp[:, :-2], vp[:, 1:-1], vp[:, 2:]], axis=2)
    scale = dh ** -0.5
    s_loc = jnp.einsum('bnqhgd,bnjhd->bnhgqj', qb, kw).astype(jnp.float32) * scale
    s_ctx = jnp.einsum('bnqhgd,bchd->bnhgqc', qb, kc).astype(jnp.float32) * scale
    q_pos = (jnp.arange(nb) * BLK)[:, None] + jnp.arange(BLK)[None, :]
    k_pos = (jnp.arange(nb) * BLK - BLK)[:, None] + jnp.arange(3 * BLK)[None, :]
    rel = q_pos[:, :, None] - k_pos[:, None, :]
    valid = (jnp.abs(rel) <= WINDOW) & (k_pos[:, None, :] >= 0) & (k_pos[:, None, :] < L)
    s_loc = jnp.where(valid[None, :, None, None], s_loc, -jnp.inf)
    s_sink = jnp.broadcast_to(sink.astype(jnp.float32).reshape(1, 1, hkv, g, 1, 1), s_loc.shape[:-1] + (1,))
    p = jax.nn.softmax(jnp.concatenate([s_loc, s_ctx, s_sink], axis=-1), axis=-1)
    nloc = 3 * BLK
    p_loc = p[..., :nloc].astype(v.dtype)
    p_ctx = p[..., nloc:nloc + lc].astype(v.dtype)
    o = jnp.einsum('bnhgqj,bnjhd->bnqhgd', p_loc, vw) + jnp.einsum('bnhgqc,bchd->bnqhgd', p_ctx, vc)
    return o.reshape(b, L, hq * dh)


def grid_attention(q, k, v, kc, vc):
    b, L, hq, dh = q.shape
    nb = L // BLK
    k_all = jnp.concatenate([k, kc], axis=1)
    v_all = jnp.concatenate([v, vc], axis=1)
    qb = jnp.moveaxis(q.reshape(b, nb, BLK, hq, dh), 1, 0)
    ob = lax.map(lambda qi: dense_attention(qi, k_all, v_all, None), qb)
    return jnp.moveaxis(ob, 0, 1).reshape(b, L, hq * dh)


def ssm_inputs(xbc_raw, dt_raw, conv_w, conv_b, dt_bias):
    b, L, _ = xbc_raw.shape
    xbc = jax.nn.silu(dwconv(xbc_raw, conv_w, conv_b))
    xs = xbc[..., :SSM_INNER].reshape(b, L, SSM_HEADS, SSM_HEADDIM)
    bm = xbc[..., SSM_INNER:SSM_INNER + SSM_BC].reshape(b, L, SSM_GROUPS, SSM_STATE)
    cm = xbc[..., SSM_INNER + SSM_BC:].reshape(b, L, SSM_GROUPS, SSM_STATE)
    dt = jax.nn.softplus(dt_raw.astype(jnp.float32).reshape(b, L, 2, SSM_HEADS) + dt_bias.astype(jnp.float32))
    return xs, bm, cm, dt


def ssd_scan(xh, dt, a_coef, bm, cm, h0, want_y):
    b, L, H, P = xh.shape
    G, N = bm.shape[2], bm.shape[3]
    hg = H // G
    q = SSM_CHUNK
    nc = L // q
    f32 = jnp.float32
    xdt = (xh.astype(f32) * dt[..., None]).reshape(b, nc, q, G, hg, P)
    bc = bm.astype(f32).reshape(b, nc, q, G, N)
    cc = cm.astype(f32).reshape(b, nc, q, G, N)
    acs = jnp.cumsum((dt * a_coef.astype(f32)).reshape(b, nc, q, G, hg), axis=2)
    decay_end = jnp.exp(acs[:, :, -1:] - acs)
    states = jnp.einsum('bcjgn,bcjghp->bcghpn', bc, xdt * decay_end[..., None])
    chunk_decay = jnp.exp(acs[:, :, -1])

    def step(h, inp):
        st, dec = inp
        return h * dec[..., None, None] + st, h

    h_last, h_in = lax.scan(step, h0.reshape(b, G, hg, P, N),
                            (jnp.moveaxis(states, 1, 0), jnp.moveaxis(chunk_decay, 1, 0)))
    h_last = h_last.reshape(b, H, P, N)
    if not want_y:
        return None, h_last
    h_in = jnp.moveaxis(h_in, 0, 1)
    seg = acs[:, :, :, None] - acs[:, :, None, :]
    tri = jnp.tril(jnp.ones((q, q), dtype=bool))
    lmat = jnp.exp(jnp.where(tri[:, :, None, None], seg, -jnp.inf))
    cb = jnp.einsum('bcign,bcjgn->bcijg', cc, bc)
    y_diag = jnp.einsum('bcijgh,bcjghp->bcighp', cb[..., None] * lmat, xdt)
    y_off = jnp.einsum('bcign,bcghpn->bcighp', cc, h_in) * jnp.exp(acs)[..., None]
    y = (y_diag + y_off).reshape(b, L, H, P).astype(xh.dtype)
    return y, h_last


def ssm_output(yf, yb, xs, z, d_skip, norm_g):
    b, L = xs.shape[0], xs.shape[1]
    y = yf + yb + xs * d_skip[:, None].astype(xs.dtype)
    y = y.reshape(b, L, SSM_INNER)
    return rms_norm(y * jax.nn.silu(z), norm_g)


def merge_branches(ya, yb, yc, g_raw, w_oa, w_ob, w_oc, w_out):
    g = jax.nn.sigmoid(g_raw.astype(jnp.float32)).astype(ya.dtype)
    ga, gb, gc = jnp.split(g, 3, axis=-1)
    m = ga * (ya @ w_oa) + gb * (yb @ w_ob) + gc * (yc @ w_oc)
    return m @ w_out


def conv_ffn(h, w_up, w_gate, conv_w, conv_b, w_down):
    up = h @ w_up
    gt = dwconv(h @ w_gate, conv_w, conv_b)
    return (jax.nn.silu(gt) * up) @ w_down


def hybrid_layer(x, xc, c_mod, cc_mod, cos, sin, w_in, norm1, norm2, a_sink, ssm_conv_w, ssm_conv_b,
                 ssm_a_log, ssm_dt_bias, ssm_d, ssm_norm, c_q_norm, c_k_norm, w_oa, w_ob, w_oc, w_out,
                 ffn_w_up, ffn_w_gate, ffn_conv_w, ffn_conv_b, ffn_w_down, need_ctx_out):
    b, L, _ = x.shape
    lc = xc.shape[1]
    sp = _in_spans()
    shift1, scale1, gate1, shift2, scale2, gate2 = jnp.split(c_mod[:, None, :], 6, axis=-1)
    h = modulate(rms_norm(x, norm1), shift1, scale1)
    hc = modulate(rms_norm(xc, norm1), cc_mod[:D_MODEL], cc_mod[D_MODEL:2 * D_MODEL])
    u = h @ w_in

    def lat(name):
        return u[..., sp[name][0]:sp[name][1]]

    def ctxp(name):
        return hc @ w_in[:, sp[name][0]:sp[name][1]]

    qa = apply_rope(lat('a_q').reshape(b, L, A_HEADS, HEAD_DIM), cos, sin)
    ka = apply_rope(lat('a_k').reshape(b, L, A_KV_HEADS, HEAD_DIM), cos, sin)
    va = lat('a_v').reshape(b, L, A_KV_HEADS, HEAD_DIM)
    kac = ctxp('a_k').reshape(b, lc, A_KV_HEADS, HEAD_DIM)
    vac = ctxp('a_v').reshape(b, lc, A_KV_HEADS, HEAD_DIM)
    ya = window_attention(qa, ka, va, kac, vac, a_sink)

    qg = apply_rope(rms_norm(lat('c_q').reshape(b, L, C_HEADS, HEAD_DIM), c_q_norm), cos, sin)
    kg = apply_rope(rms_norm(lat('c_k').reshape(b, L, C_KV_HEADS, HEAD_DIM), c_k_norm), cos, sin)
    vg = lat('c_v').reshape(b, L, C_KV_HEADS, HEAD_DIM)
    kgc = rms_norm(ctxp('c_k').reshape(b, lc, C_KV_HEADS, HEAD_DIM), c_k_norm)
    vgc = ctxp('c_v').reshape(b, lc, C_KV_HEADS, HEAD_DIM)
    yg = grid_attention(qg, kg, vg, kgc, vgc)

    a_coef = -jnp.exp(ssm_a_log.astype(jnp.float32))
    xs_c, bm_c, cm_c, dt_c = ssm_inputs(ctxp('b_xbc'), ctxp('b_dt'), ssm_conv_w, ssm_conv_b, ssm_dt_bias)
    h0 = jnp.zeros((b, SSM_HEADS, SSM_HEADDIM, SSM_STATE), jnp.float32)
    yf_c, hf_c = ssd_scan(xs_c, dt_c[:, :, 0], a_coef[0], bm_c, cm_c, h0, need_ctx_out)
    yb_c, hb_c = ssd_scan(jnp.flip(xs_c, 1), jnp.flip(dt_c[:, :, 1], 1), a_coef[1],
                          jnp.flip(bm_c, 1), jnp.flip(cm_c, 1), h0, need_ctx_out)
    xs, bm, cm, dt = ssm_inputs(lat('b_xbc'), lat('b_dt'), ssm_conv_w, ssm_conv_b, ssm_dt_bias)
    yf, _ = ssd_scan(xs, dt[:, :, 0], a_coef[0], bm, cm, hf_c, True)
    yb, _ = ssd_scan(jnp.flip(xs, 1), jnp.flip(dt[:, :, 1], 1), a_coef[1],
                     jnp.flip(bm, 1), jnp.flip(cm, 1), hb_c, True)
    ys = ssm_output(yf, jnp.flip(yb, 1), xs, lat('b_z'), ssm_d, ssm_norm)

    x = x + gate1 * merge_branches(ya, ys, yg, lat('gates'), w_oa, w_ob, w_oc, w_out)
    h2 = modulate(rms_norm(x, norm2), shift2, scale2)
    x = x + gate2 * conv_ffn(h2, ffn_w_up, ffn_w_gate, ffn_conv_w, ffn_conv_b, ffn_w_down)
    if not need_ctx_out:
        return x, None

    cgate1 = cc_mod[2 * D_MODEL:3 * D_MODEL]
    cshift2 = cc_mod[3 * D_MODEL:4 * D_MODEL]
    cscale2 = cc_mod[4 * D_MODEL:5 * D_MODEL]
    cgate2 = cc_mod[5 * D_MODEL:]
    yac = dense_attention(ctxp('a_q').reshape(b, lc, A_HEADS, HEAD_DIM), kac, vac, a_sink)
    ygc = dense_attention(rms_norm(ctxp('c_q').reshape(b, lc, C_HEADS, HEAD_DIM), c_q_norm), kgc, vgc, None)
    ysc = ssm_output(yf_c, jnp.flip(yb_c, 1), xs_c, ctxp('b_z'), ssm_d, ssm_norm)
    xc = xc + cgate1 * merge_branches(yac, ysc, ygc, ctxp('gates'), w_oa, w_ob, w_oc, w_out)
    h2c = modulate(rms_norm(xc, norm2), cshift2, cscale2)
    xc = xc + cgate2 * conv_ffn(h2c, ffn_w_up, ffn_w_gate, ffn_conv_w, ffn_conv_b, ffn_w_down)
    return x, xc


def setup_inputs(seed: int = 0) -> dict:
    key = jax.random.key(seed)
    ks = jax.random.split(key, 32)
    f32 = jnp.float32

    def nrm(k, shape, scale):
        return jax.random.normal(k, shape, f32) * scale

    d = D_MODEL
    dt0 = jnp.exp(jax.random.uniform(ks[11], (DEPTH, 2, SSM_HEADS), f32, math.log(1e-3), math.log(1e-1)))
    return {
        'x': nrm(ks[0], (BATCH, SEQ, d), 1.0),
        'c': nrm(ks[1], (BATCH, d), 1.0),
        'ctx': nrm(ks[2], (BATCH, CTX_LEN, d), 1.0),
        'c_ctx': nrm(ks[3], (d,), 1.0),
        'w_mod': nrm(ks[4], (DEPTH, d, 6 * d), 0.5 * d ** -0.5),
        'b_mod': nrm(ks[5], (DEPTH, 6 * d), 0.02),
        'norm1': 1.0 + nrm(ks[6], (DEPTH, d), 0.05),
        'norm2': 1.0 + nrm(ks[7], (DEPTH, d), 0.05),
        'w_in': nrm(ks[8], (DEPTH, d, IN_WIDTH), d ** -0.5),
        'a_sink': nrm(ks[9], (DEPTH, A_HEADS), 0.5),
        'ssm_conv_w': nrm(ks[10], (DEPTH, SSM_CONV, SSM_XBC), SSM_CONV ** -0.5),
        'ssm_conv_b': nrm(ks[12], (DEPTH, SSM_XBC), 0.02),
        'ssm_A_log': jnp.log(jax.random.uniform(ks[13], (DEPTH, 2, SSM_HEADS), f32, 1.0, 16.0)),
        'ssm_dt_bias': dt0 + jnp.log(-jnp.expm1(-dt0)),
        'ssm_D': 1.0 + nrm(ks[14], (DEPTH, SSM_HEADS), 0.1),
        'ssm_norm': 1.0 + nrm(ks[15], (DEPTH, SSM_INNER), 0.05),
        'c_q_norm': 1.0 + nrm(ks[16], (DEPTH, HEAD_DIM), 0.05),
        'c_k_norm': 1.0 + nrm(ks[17], (DEPTH, HEAD_DIM), 0.05),
        'w_oa': nrm(ks[18], (DEPTH, A_Q_W, d), A_Q_W ** -0.5),
        'w_ob': nrm(ks[19], (DEPTH, SSM_INNER, d), SSM_INNER ** -0.5),
        'w_oc': nrm(ks[20], (DEPTH, C_Q_W, d), C_Q_W ** -0.5),
        'w_out': nrm(ks[21], (DEPTH, d, d), d ** -0.5),
        'ffn_w_up': nrm(ks[22], (DEPTH, d, D_FF), d ** -0.5),
        'ffn_w_gate': nrm(ks[23], (DEPTH, d, D_FF), d ** -0.5),
        'ffn_conv_w': nrm(ks[24], (DEPTH, FFN_CONV, D_FF), FFN_CONV ** -0.5),
        'ffn_conv_b': nrm(ks[25], (DEPTH, D_FF), 0.02),
        'ffn_w_down': nrm(ks[26], (DEPTH, D_FF, d), D_FF ** -0.5),
        'final_norm': 1.0 + nrm(ks[27], (d,), 0.05),
    }


def reference(x, c, ctx, c_ctx, w_mod, b_mod, norm1, norm2, w_in, a_sink, ssm_conv_w, ssm_conv_b,
              ssm_A_log, ssm_dt_bias, ssm_D, ssm_norm, c_q_norm, c_k_norm, w_oa, w_ob, w_oc, w_out,
              ffn_w_up, ffn_w_gate, ffn_conv_w, ffn_conv_b, ffn_w_down, final_norm):
    rows = x.shape[1] // GRID_W
    cos, sin = grid_rope(rows)
    xc = ctx
    sc = jax.nn.silu(c)
    scc = jax.nn.silu(c_ctx)
    for l in range(DEPTH):
        need_ctx_out = l < DEPTH - 1
        n_cmod = 6 * D_MODEL if need_ctx_out else 2 * D_MODEL
        c_mod = sc @ w_mod[l] + b_mod[l]
        cc_mod = scc @ w_mod[l][:, :n_cmod] + b_mod[l][:n_cmod]
        x, xc = hybrid_layer(x, xc, c_mod, cc_mod, cos, sin, w_in[l], norm1[l], norm2[l], a_sink[l],
                             ssm_conv_w[l], ssm_conv_b[l], ssm_A_log[l], ssm_dt_bias[l], ssm_D[l],
                             ssm_norm[l], c_q_norm[l], c_k_norm[l], w_oa[l], w_ob[l], w_oc[l], w_out[l],
                             ffn_w_up[l], ffn_w_gate[l], ffn_conv_w[l], ffn_conv_b[l], ffn_w_down[l],
                             need_ctx_out)
    return rms_norm(x, final_norm)
```

```cpp
#include <hip/hip_runtime.h>
#include <hip/hip_cooperative_groups.h>
#include <cstdio>
namespace cg = cooperative_groups;

#define DI __device__ __forceinline__
#define LAS __attribute__((address_space(3)))
typedef unsigned short us;
typedef __attribute__((ext_vector_type(8))) __bf16 b16x8;
typedef __attribute__((ext_vector_type(2))) __bf16 b16x2;
typedef __attribute__((ext_vector_type(16))) float f32x16;
typedef __attribute__((ext_vector_type(4))) float f32x4;
typedef __attribute__((ext_vector_type(4))) unsigned u32x4;
typedef __attribute__((ext_vector_type(2))) unsigned u32x2;

constexpr int NB = 4, SEQL = 4096, DM = 1024, LC = 256, POS = LC + SEQL, R = NB * POS;
constexpr int INW = 7200, DFF = 2816;
constexpr int MT = R / 256;
constexpr float EPS = 1e-6f;
constexpr float LOG2E = 1.4426950408889634f;

constexpr size_t S1 = (size_t)R * 1024 * 2, S05 = S1 / 2, S025 = S1 / 4, S0125 = S1 / 8, S15 = S1 + S05;
constexpr size_t EL_WIN = (size_t)7296 * 1024, EL_WOA = 1024 * 512, EL_WOB = 1024 * 1024, EL_WOC = 1024 * 512, EL_WOUT = 1024 * 1024,
                 EL_WUG = (size_t)5632 * 1024, EL_WDN = (size_t)1024 * 2816;
constexpr size_t W_WIN = 0, W_WOA = W_WIN + EL_WIN, W_WOB = W_WOA + EL_WOA, W_WOC = W_WOB + EL_WOB, W_WOUT = W_WOC + EL_WOC,
                 W_WUG = W_WOUT + EL_WOUT, W_WDN = W_WUG + EL_WUG, W_END = W_WDN + EL_WDN;
constexpr size_t OFF_R1 = W_END * 2;
constexpr size_t OFF_H = OFF_R1, OFF_XBCRAW = OFF_R1 + S1;
constexpr size_t OFF_YF = OFF_R1 + S1, OFF_YB = OFF_R1 + 2 * S1;
constexpr size_t OFF_ACT = OFF_R1;
constexpr size_t OFF_R2 = OFF_R1 + 3 * S1;
constexpr size_t OFF_QA = OFF_R2, OFF_QC = OFF_QA + S05, OFF_KA = OFF_QC + S05, OFF_KC = OFF_KA + S0125, OFF_VAT = OFF_KC + S0125, OFF_VCT = OFF_VAT + S0125;
constexpr size_t OFF_YA = OFF_QA, OFF_YC = OFF_QC;
constexpr size_t OFF_H2 = OFF_R2;
constexpr size_t OFF_R3 = OFF_R2 + S15;
constexpr size_t OFF_XT = OFF_R3, OFF_BN = OFF_XT + S1, OFF_BT = OFF_BN + S025, OFF_CN = OFF_BT + S025;
constexpr size_t OFF_M = OFF_R3, OFF_XC = OFF_R3 + S1;
constexpr size_t OFF_DT = OFF_R3 + S1 + 3 * S025;
constexpr size_t OFF_CMOD = OFF_DT + (size_t)R * 32 * 4;
constexpr size_t OFF_PART = OFF_CMOD + 2 * 5 * 6144 * 4;
constexpr size_t OFF_ROPE = OFF_PART + (size_t)R * 8 * 4;
constexpr size_t OFF_CTL = OFF_ROPE + 4096 * 32 * 8;
constexpr size_t OFF_BAR = OFF_CTL + 256;
constexpr size_t OFF_HMID = OFF_BAR + 14080;
constexpr size_t OFF_CUMP = OFF_HMID + (size_t)128 * 8192 * 2;
constexpr size_t WS_NEED = OFF_CUMP + 128 * 34 * 4;
struct Params {
  const float *x, *c, *ctx, *c_ctx, *w_mod, *b_mod, *norm1, *norm2, *w_in, *a_sink, *ssm_conv_w, *ssm_conv_b, *ssm_A_log, *ssm_dt_bias,
      *ssm_D, *ssm_norm, *c_q_norm, *c_k_norm, *w_oa, *w_ob, *w_oc, *w_out, *ffn_w_up, *ffn_w_gate, *ffn_conv_w, *ffn_conv_b, *ffn_w_down, *final_norm;
  float* out;
  unsigned char* ws;
  int ph_lo, ph_hi;
};

DI unsigned pk2(float a, float b) { b16x2 v; v[0] = (__bf16)a; v[1] = (__bf16)b; return __builtin_bit_cast(unsigned, v); }
DI us f2bf(float a) { __bf16 v = (__bf16)a; return __builtin_bit_cast(us, v); }
DI float bflo(unsigned u) { return __uint_as_float(u << 16); }
DI float bfhi(unsigned u) { return __uint_as_float(u & 0xffff0000u); }
DI float bf2f(us u) { return __uint_as_float(((unsigned)u) << 16); }
DI int tidx() { int t = threadIdx.x; asm volatile("" : "+v"(t) :: "memory"); return t; }
DI int crow(int reg, int h) { return (reg & 3) + 8 * (reg >> 2) + 4 * h; }
DI float silu(float v) { return v * __builtin_amdgcn_rcpf(1.f + __expf(-v)); }
DI float sigmoidf(float v) { return __builtin_amdgcn_rcpf(1.f + __expf(-v)); }
DI f32x16 mfma(b16x8 a, b16x8 b, f32x16 c) { return __builtin_amdgcn_mfma_f32_32x32x16_bf16(a, b, c, 0, 0, 0); }
DI b16x8 ldsfrag(const unsigned char* p) { return __builtin_bit_cast(b16x8, *(const u32x4*)p); }
DI b16x8 ldsfrag2(const unsigned char* p0, const unsigned char* p1) {
  u32x2 a = *(const u32x2*)p0, b = *(const u32x2*)p1; u32x4 v; v[0] = a[0]; v[1] = a[1]; v[2] = b[0]; v[3] = b[1];
  return __builtin_bit_cast(b16x8, v);
}
DI f32x16 fzero() { f32x16 z; for (int i = 0; i < 16; ++i) z[i] = 0.f; return z; }

DI const float* xrow_r(const Params& p, bool use_in, int row) {
  int b = row / POS, pos = row - b * POS;
  if (pos < LC) return (use_in ? p.ctx : (const float*)(p.ws + OFF_XC)) + ((size_t)(b * LC + pos)) * DM;
  return (use_in ? p.x : (const float*)p.out) + ((size_t)(b * SEQL + pos - LC)) * DM;
}
DI float* xrow_w(const Params& p, int row) {
  int b = row / POS, pos = row - b * POS;
  if (pos < LC) return (float*)(p.ws + OFF_XC) + ((size_t)(b * LC + pos)) * DM;
  return p.out + ((size_t)(b * SEQL + pos - LC)) * DM;
}
DI const float* cmod_row(const Params& p, int l, int row) {
  int b = row / POS, pos = row - b * POS;
  int s = pos < LC ? 4 : b;
  return (const float*)(p.ws + OFF_CMOD) + ((size_t)(l * 5 + s)) * 6144;
}

#define TW 0
constexpr int NTHR = 512;
constexpr int STG = 73728;
constexpr int LDS_MAIN = 2 * STG, LDS_BYTES = LDS_MAIN + 2048;

template <int NBW, int MB = 4>
DI void gemm_tile(f32x16 (&acc)[MB][NBW], const us* A, long lda, int r_lo, int r_hi, const us* Bt, long ldb, int K, unsigned char* smem) {
  const int t = tidx(), lane = t & 63, w = t >> 6, r = lane & 31, h = lane >> 5, wm = w >> 2, wn = w & 3;
  u32x4 pa[MB], pb[2 * NBW];
  const int lrow = t >> 3, lch = t & 7;
  const us* Ap = A + (long)lrow * lda + lch * 8;
  const us* Bp = Bt + (long)lrow * ldb + lch * 8;
  bool av[MB];
#pragma unroll
  for (int i = 0; i < MB; ++i) av[i] = (lrow + 64 * i) >= r_lo && (lrow + 64 * i) < r_hi;
  auto gload = [&](int k0) {
#pragma unroll
    for (int i = 0; i < MB; ++i) {
      if (av[i]) pa[i] = *(const u32x4*)(Ap + (long)(64 * i) * lda + k0);
      else { pa[i][0] = 0; pa[i][1] = 0; pa[i][2] = 0; pa[i][3] = 0; }
    }
#pragma unroll
    for (int i = 0; i < 2 * NBW; ++i) pb[i] = *(const u32x4*)(Bp + (long)(64 * i) * ldb + k0);
  };
  auto lstore = [&](int st) {
    unsigned char* As = smem + st * STG + lrow * 144 + lch * 16; unsigned char* Bs = As + 36864;
#pragma unroll
    for (int i = 0; i < MB; ++i) *(u32x4*)(As + i * 64 * 144) = pa[i];
#pragma unroll
    for (int i = 0; i < 2 * NBW; ++i) *(u32x4*)(Bs + i * 64 * 144) = pb[i];
  };
  auto compute = [&](int st, int ks0, int ks1) {
    const unsigned char* As = smem + st * STG + (wm * 32 * MB + r) * 144 + 16 * h;
    const unsigned char* Bs = smem + st * STG + 36864 + (wn * 32 * NBW + r) * 144 + 16 * h;
#pragma unroll
    for (int ks = ks0; ks < ks1; ++ks) {
      b16x8 fa[MB], fb[NBW];
#pragma unroll
      for (int mb = 0; mb < MB; ++mb) fa[mb] = ldsfrag(As + mb * 32 * 144 + ks * 32);
#pragma unroll
      for (int nb = 0; nb < NBW; ++nb) fb[nb] = ldsfrag(Bs + nb * 32 * 144 + ks * 32);
#pragma unroll
      for (int nb = 0; nb < NBW; ++nb)
#pragma unroll
        for (int mb = 0; mb < MB; ++mb) acc[mb][nb] = mfma(fa[mb], fb[nb], acc[mb][nb]);
    }
  };
#pragma unroll
  for (int i = 0; i < MB; ++i)
#pragma unroll
    for (int j = 0; j < NBW; ++j) acc[i][j] = fzero();
  const int nk = K / 64;
  gload(0); lstore(0);
  __syncthreads();
  for (int kt = 0; kt < nk; ++kt) {
    if (kt + 1 < nk) gload((kt + 1) * 64);
    if (NBW == 2 && MB == 4) {
      __builtin_amdgcn_sched_barrier(0);
      compute(kt & 1, 0, 3);
      __builtin_amdgcn_sched_barrier(0);
      compute(kt & 1, 3, 4);
      if (kt + 1 < nk) lstore((kt + 1) & 1);
      __builtin_amdgcn_sched_group_barrier(0x100, 6, 0);
#pragma unroll
      for (int i = 0; i < 8; ++i) { __builtin_amdgcn_sched_group_barrier(0x008, 1, 0); __builtin_amdgcn_sched_group_barrier(0x200, 1, 0); }
      __builtin_amdgcn_sched_barrier(0);
    } else {
      compute(kt & 1, 0, 4);
      if (kt + 1 < nk) lstore((kt + 1) & 1);
    }
    __syncthreads();
  }
}
DI f32x4 mfma16(b16x8 a, b16x8 b, f32x4 c) { return __builtin_amdgcn_mfma_f32_16x16x32_bf16(a, b, c, 0, 0, 0); }
template <int NBW>
DI void gemm_tile16(f32x4 (&acc)[8][2 * NBW], const us* A, long lda, int r_lo, int r_hi, const us* Bt, long ldb, int K, unsigned char* smem) {
  const int t = tidx(), lane = t & 63, w = t >> 6, r = lane & 15, quad = lane >> 4, wm = w >> 2, wn = w & 3;
  const int srow = lane >> 3, spos = lane & 7;
  auto stage = [&](int st, int k0) {
#pragma unroll
    for (int i = 0; i < 4; ++i) {
      const int row = w * 32 + i * 8 + srow;
      int rs_ = row < r_lo ? r_lo : row; rs_ = rs_ >= r_hi ? r_hi - 1 : rs_;
      const us* src = A + (long)rs_ * lda + k0 + ((spos ^ ((row >> 1) & 7)) << 3);
      __builtin_amdgcn_global_load_lds((const unsigned*)src, (LAS unsigned*)(smem + st * STG + (w * 32 + i * 8) * 128), 16, 0, 0);
    }
#pragma unroll
    for (int i = 0; i < 2 * NBW; ++i) {
      const int row = w * 16 * NBW + i * 8 + srow;
      const us* src = Bt + (long)row * ldb + k0 + ((spos ^ ((row >> 1) & 7)) << 3);
      __builtin_amdgcn_global_load_lds((const unsigned*)src, (LAS unsigned*)(smem + st * STG + 32768 + (w * 16 * NBW + i * 8) * 128), 16, 0, 0);
    }
  };
  auto compute = [&](int st, int ks0, int ks1) {
    const unsigned char* Ab = smem + st * STG + (wm * 128 + r) * 128;
    const unsigned char* Bb = smem + st * STG + 32768 + (wn * 32 * NBW + r) * 128;
    const int g = (r >> 1) & 7;
#pragma unroll
    for (int ks = ks0; ks < ks1; ++ks) {
      const int off = ((((ks * 4) ^ (g & 4)) + (quad ^ (g & 3))) << 4);
      b16x8 fb[2 * NBW];
#pragma unroll
      for (int nt = 0; nt < 2 * NBW; ++nt) fb[nt] = ldsfrag(Bb + nt * 16 * 128 + off);
#pragma unroll
      for (int hf = 0; hf < 2; ++hf) {
        b16x8 fa[4];
#pragma unroll
        for (int m = 0; m < 4; ++m) fa[m] = ldsfrag(Ab + (hf * 4 + m) * 16 * 128 + off);
#pragma unroll
        for (int m = 0; m < 4; ++m)
#pragma unroll
          for (int nt = 0; nt < 2 * NBW; ++nt) acc[hf * 4 + m][nt] = mfma16(fa[m], fb[nt], acc[hf * 4 + m][nt]);
      }
    }
  };
#pragma unroll
  for (int i = 0; i < 8; ++i)
#pragma unroll
    for (int j = 0; j < 2 * NBW; ++j) { acc[i][j][0] = 0.f; acc[i][j][1] = 0.f; acc[i][j][2] = 0.f; acc[i][j][3] = 0.f; }
  const int nk = K / 64;
  stage(0, 0);
  asm volatile("s_waitcnt vmcnt(0)" ::: "memory");
  __syncthreads();
  for (int kt = 0; kt < nk; ++kt) {
    if (kt + 1 < nk) stage((kt + 1) & 1, (kt + 1) * 64);
#pragma unroll
    for (int ks = 0; ks < 2; ++ks) {
      __builtin_amdgcn_sched_barrier(0);
      compute(kt & 1, ks, ks + 1);
      if (NBW == 2) {
        __builtin_amdgcn_sched_group_barrier(0x100, 12, 0); __builtin_amdgcn_sched_group_barrier(0x008, 32, 0);
      } else {
        __builtin_amdgcn_sched_group_barrier(0x100, 6, 0); __builtin_amdgcn_sched_group_barrier(0x008, 6, 0);
        __builtin_amdgcn_sched_group_barrier(0x100, 4, 0); __builtin_amdgcn_sched_group_barrier(0x008, 10, 0);
      }
    }
    __builtin_amdgcn_sched_barrier(0);
    asm volatile("s_waitcnt vmcnt(0)" ::: "memory");
    __syncthreads();
  }
}
template <int NBW>
DI void acc_to_lds16(const f32x4 (&acc)[8][2 * NBW], int half, unsigned char* smem) {
  const int t = tidx(), lane = t & 63, w = t >> 6, r = lane & 15, quad = lane >> 4, wm = w >> 2, wn = w & 3;
  float* Cs = (float*)smem;
  if (NBW == 2 && (wn >> 1) != half) return;
  const int cbase = (NBW == 2) ? (wn & 1) * 64 : wn * 32;
#pragma unroll
  for (int mt = 0; mt < 8; ++mt)
#pragma unroll
    for (int nt = 0; nt < 2 * NBW; ++nt)
#pragma unroll
      for (int i = 0; i < 4; ++i) Cs[(wm * 128 + mt * 16 + quad * 4 + i) * 132 + cbase + nt * 16 + r] = acc[mt][nt][i];
}
template <int NBW, int MB = 4>
DI void acc_to_lds(const f32x16 (&acc)[MB][NBW], int half, unsigned char* smem) {
  const int t = tidx(), lane = t & 63, w = t >> 6, r = lane & 31, h = lane >> 5, wm = w >> 2, wn = w & 3;
  float* Cs = (float*)smem;
  if (NBW == 2 && (wn >> 1) != half) return;
  const int cbase = (NBW == 2) ? (wn & 1) * 64 : wn * 32;
#pragma unroll
  for (int mb = 0; mb < MB; ++mb)
#pragma unroll
    for (int nb = 0; nb < NBW; ++nb)
#pragma unroll
      for (int i = 0; i < 16; ++i) Cs[(wm * 32 * MB + mb * 32 + crow(i, h)) * 132 + cbase + nb * 32 + r] = acc[mb][nb][i];
}
DI void lds_row8(const unsigned char* smem, int row, int cg8, float (&v)[8]) {
  const float* Cs = (const float*)smem + row * 132 + cg8 * 8;
  f32x4 a = *(const f32x4*)Cs, b = *(const f32x4*)(Cs + 4);
  v[0] = a[0]; v[1] = a[1]; v[2] = a[2]; v[3] = a[3]; v[4] = b[0]; v[5] = b[1]; v[6] = b[2]; v[7] = b[3];
}
DI void store8bf(us* dst, const float (&v)[8]) {
  u32x4 o; o[0] = pk2(v[0], v[1]); o[1] = pk2(v[2], v[3]); o[2] = pk2(v[4], v[5]); o[3] = pk2(v[6], v[7]);
  *(u32x4*)dst = o;
}
DI void load8bf(const us* src, float (&v)[8]) {
  u32x4 o = *(const u32x4*)src;
  v[0] = bflo(o[0]); v[1] = bfhi(o[0]); v[2] = bflo(o[1]); v[3] = bfhi(o[1]); v[4] = bflo(o[2]); v[5] = bfhi(o[2]); v[6] = bflo(o[3]); v[7] = bfhi(o[3]);
}

DI void cmod_item(const Params& p, int it, unsigned char* smem) {
  const int t = tidx();
  float* sv = (float*)smem;
  float* red = sv + 5 * 1024;
  for (int i = t; i < 5 * 1024; i += NTHR) {
    int s = i >> 10, k = i & 1023;
    float v = s < 4 ? p.c[s * 1024 + k] : p.c_ctx[k];
    sv[i] = v / (1.f + expf(-v));
  }
  __syncthreads();
  const int l = it / 96, n0 = (it % 96) * 64, col = t & 63, kg = t >> 6;
  const float* W = p.w_mod + (size_t)l * 1024 * 6144 + n0 + col;
  float a0 = 0, a1 = 0, a2 = 0, a3 = 0, a4 = 0;
  for (int k = kg * 128; k < kg * 128 + 128; ++k) {
    float wv = W[(size_t)k * 6144];
    a0 += sv[k] * wv; a1 += sv[1024 + k] * wv; a2 += sv[2048 + k] * wv; a3 += sv[3072 + k] * wv; a4 += sv[4096 + k] * wv;
  }
  red[(kg * 5 + 0) * 64 + col] = a0; red[(kg * 5 + 1) * 64 + col] = a1; red[(kg * 5 + 2) * 64 + col] = a2;
  red[(kg * 5 + 3) * 64 + col] = a3; red[(kg * 5 + 4) * 64 + col] = a4;
  __syncthreads();
  if (t < 320) {
    int s = t >> 6, cc = t & 63;
    float v = 0.f;
#pragma unroll
    for (int g = 0; g < 8; ++g) v += red[(g * 5 + s) * 64 + cc];
    v += p.b_mod[l * 6144 + n0 + cc];
    ((float*)(p.ws + OFF_CMOD))[((size_t)(l * 5 + s)) * 6144 + n0 + cc] = v;
  }
  __syncthreads();
}
DI void rope_item(const Params& p, int it) {
  int idx = it * NTHR + tidx();
  int tok = idx >> 5, i = idx & 31;
  float inv = exp2f(-(float)(i & 15) * (13.287712379549449f / 16.f));
  float pos = (i < 16) ? (float)(tok >> 6) : (float)(tok & 63);
  float ang = pos * inv;
  float* T = (float*)(p.ws + OFF_ROPE);
  T[idx * 2] = cosf(ang); T[idx * 2 + 1] = sinf(ang);
}
constexpr int NCONV_ITEMS = 2352;
constexpr int NCONV_EARLY = 400;
DI void convw_item(const Params& p, int l, int it, unsigned char* smem) {
  const float* src; int ld, col0, nvalid, K, blk, off; size_t dsto; int nblk;
  us* Wb = (us*)p.ws;
  const float* win = p.w_in + (size_t)l * 1024 * INW;
  int j = 0, base = 0;
#define CJ(n) if (j == base && it >= acc_ + (n)) { acc_ += (n); ++j; } ++base;
  int acc_ = 0;
  CJ(96) CJ(96) CJ(192) CJ(16) CJ(128) CJ(384) CJ(64) CJ(128) CJ(64) CJ(128) CJ(352) CJ(352)
#undef CJ
  int loc = it - acc_;
  switch (j) {
    case 0: src = win; ld = INW; col0 = 0; nvalid = 768; nblk = 12; K = 1024; dsto = W_WIN; blk = 64; off = 0; break;
    case 1: src = win; ld = INW; col0 = 3360; nvalid = 768; nblk = 12; K = 1024; dsto = W_WIN + (size_t)768 * 1024; blk = 64; off = 0; break;
    case 2: src = win; ld = INW; col0 = 1792; nvalid = 1536; nblk = 24; K = 1024; dsto = W_WIN + (size_t)1536 * 1024; blk = 64; off = 0; break;
    case 3: src = win; ld = INW; col0 = 3328; nvalid = 32; nblk = 2; K = 1024; dsto = W_WIN + (size_t)3072 * 1024; blk = 64; off = 0; break;
    case 4: src = win; ld = INW; col0 = 768; nvalid = 1024; nblk = 16; K = 1024; dsto = W_WIN + (size_t)3200 * 1024; blk = 64; off = 0; break;
    case 5: src = win; ld = INW; col0 = 4128; nvalid = 3072; nblk = 48; K = 1024; dsto = W_WIN + (size_t)4224 * 1024; blk = 64; off = 0; break;
    case 6: src = p.w_oa + (size_t)l * 512 * 1024; ld = 1024; col0 = 0; nvalid = 1024; nblk = 16; K = 512; dsto = W_WOA; blk = 64; off = 0; break;
    case 7: src = p.w_ob + (size_t)l * 1024 * 1024; ld = 1024; col0 = 0; nvalid = 1024; nblk = 16; K = 1024; dsto = W_WOB; blk = 64; off = 0; break;
    case 8: src = p.w_oc + (size_t)l * 512 * 1024; ld = 1024; col0 = 0; nvalid = 1024; nblk = 16; K = 512; dsto = W_WOC; blk = 64; off = 0; break;
    case 9: src = p.w_out + (size_t)l * 1024 * 1024; ld = 1024; col0 = 0; nvalid = 1024; nblk = 16; K = 1024; dsto = W_WOUT; blk = 64; off = 0; break;
    case 10: src = p.ffn_w_gate + (size_t)l * 1024 * DFF; ld = DFF; col0 = 0; nvalid = DFF; nblk = 44; K = 1024; dsto = W_WUG; blk = 128; off = 0; break;
    case 11: src = p.ffn_w_up + (size_t)l * 1024 * DFF; ld = DFF; col0 = 0; nvalid = DFF; nblk = 44; K = 1024; dsto = W_WUG; blk = 128; off = 64; break;
    default: src = p.ffn_w_down + (size_t)l * DFF * 1024; ld = 1024; col0 = 0; nvalid = 1024; nblk = 16; K = DFF; dsto = W_WDN; blk = 64; off = 0; break;
  }
  const int nb2 = nblk >> 1;
  const int nb0 = (loc % nb2) * 2, kb = loc / nb2;
  float* tile = (float*)smem;
  const int t = tidx(), col = t & 127, kq = t >> 7;
  const bool cv = (nb0 * 64 + col) < nvalid;
  float lv[16];
#pragma unroll
  for (int i = 0; i < 16; ++i) lv[i] = cv ? __builtin_nontemporal_load(src + (size_t)(kb * 64 + kq + 4 * i) * ld + col0 + nb0 * 64 + col) : 0.f;
#pragma unroll
  for (int i = 0; i < 16; ++i) tile[(kq + 4 * i) * 129 + col] = lv[i];
  __syncthreads();
  {
    int n = t >> 2, kc = (t & 3) * 16;
    float v[8], u[8];
#pragma unroll
    for (int q = 0; q < 8; ++q) { v[q] = tile[(kc + q) * 129 + n]; u[q] = tile[(kc + 8 + q) * 129 + n]; }
    us* dst = Wb + dsto + (size_t)((nb0 + (n >> 6)) * blk + off + (n & 63)) * K + kb * 64 + kc;
    store8bf(dst, v); store8bf(dst + 8, u);
  }
  __syncthreads();
}

DI void normmod_item(const Params& p, int l, int which, bool use_in, us* dst, int it) {
  const int lane = tidx() & 63, w = tidx() >> 6;
  const int row = it * 8 + w;
  const float* xr = xrow_r(p, use_in, row);
  const float* cm = cmod_row(p, l, row) + (which ? 3 * DM : 0);
  const float* g = (which ? p.norm2 : p.norm1) + l * DM;
  f32x4 v[4]; float ss = 0.f;
#pragma unroll
  for (int i = 0; i < 4; ++i) { v[i] = *(const f32x4*)(xr + i * 256 + lane * 4); ss += v[i][0] * v[i][0] + v[i][1] * v[i][1] + v[i][2] * v[i][2] + v[i][3] * v[i][3]; }
#pragma unroll
  for (int o = 32; o > 0; o >>= 1) ss += __shfl_xor(ss, o);
  const float rstd = rsqrtf(ss * (1.f / DM) + EPS);
#pragma unroll
  for (int i = 0; i < 4; ++i) {
    int c0 = i * 256 + lane * 4;
    f32x4 gg = *(const f32x4*)(g + c0), sh = *(const f32x4*)(cm + c0), sc = *(const f32x4*)(cm + DM + c0);
    float o0 = v[i][0] * rstd * gg[0] * (1.f + sc[0]) + sh[0], o1 = v[i][1] * rstd * gg[1] * (1.f + sc[1]) + sh[1];
    float o2 = v[i][2] * rstd * gg[2] * (1.f + sc[2]) + sh[2], o3 = v[i][3] * rstd * gg[3] * (1.f + sc[3]) + sh[3];
    u32x2 o; o[0] = pk2(o0, o1); o[1] = pk2(o2, o3);
    *(u32x2*)(dst + (size_t)row * DM + c0) = o;
  }
}

DI void inproj_epi(const Params& p, int l, int row0, int nt, unsigned char* smem) {
  const int t = tidx();
  const int b = row0 / POS, pos0 = row0 - b * POS;
  const bool latent = pos0 >= LC;
  if (nt == 5 || nt == 11) {
    us* VT = (us*)(p.ws + (nt == 5 ? OFF_VAT : OFF_VCT));
    const float* Cs = (const float*)smem;
    const int col = t & 127, rg = t >> 7;
#pragma unroll
    for (int itr = 0; itr < 8; ++itr) {
      int rr = rg * 64 + itr * 8; float v[8];
#pragma unroll
      for (int q = 0; q < 8; ++q) v[q] = Cs[(rr + q) * 132 + col];
      store8bf(VT + ((size_t)(b * 128 + col)) * POS + pos0 + rr, v);
    }
  } else if (nt == 24) {
    const float* Cs = (const float*)smem;
    float* DT = (float*)(p.ws + OFF_DT);
    for (int i = t; i < 256 * 32; i += NTHR) {
      int rr = i >> 5, cc = i & 31;
      float v = Cs[rr * 132 + cc] + p.ssm_dt_bias[l * 32 + cc];
      float e = __expf(v);
      float sp = v > 20.f ? v : (e < 0.01f ? e * (1.f - e * (0.5f - e * (1.f / 3.f))) : __logf(1.f + e));
      DT[(size_t)(row0 + rr) * 32 + cc] = sp;
    }
  } else if (nt >= 12) {
    us* X = (us*)(p.ws + OFF_XBCRAW);
    const int cg8 = t & 15;
#pragma unroll
    for (int itr = 0; itr < 8; ++itr) {
      int rr = (t >> 4) + 32 * itr; float v[8];
      lds_row8(smem, rr, cg8, v);
      store8bf(X + (size_t)(row0 + rr) * 1536 + (nt - 12) * 128 + cg8 * 8, v);
    }
  } else {
    const bool isC = nt >= 6;
    const bool isQ = isC ? (nt <= 9) : (nt <= 3);
    us* dst; int ldd, coff;
    if (!isC) { if (isQ) { dst = (us*)(p.ws + OFF_QA); ldd = 512; coff = nt * 128; } else { dst = (us*)(p.ws + OFF_KA); ldd = 128; coff = 0; } }
    else { if (isQ) { dst = (us*)(p.ws + OFF_QC); ldd = 512; coff = (nt - 6) * 128; } else { dst = (us*)(p.ws + OFF_KC); ldd = 128; coff = 0; } }
    const float* gn = isC ? ((isQ ? p.c_q_norm : p.c_k_norm) + l * 64) : nullptr;
    const float qs = isQ ? 0.125f * LOG2E : 1.f;
    const float* ROPE = (const float*)(p.ws + OFF_ROPE);
    const int cg8 = t & 15, d0 = (cg8 & 7) * 8;
    float gnv[8];
#pragma unroll
    for (int q = 0; q < 8; ++q) gnv[q] = isC ? gn[d0 + q] : 1.f;
#pragma unroll
    for (int ib4 = 0; ib4 < 8; ib4 += 4) {
    f32x4 rc[4][2];
    if (latent) {
#pragma unroll
      for (int i4 = 0; i4 < 4; ++i4) {
        const float* cs = ROPE + ((size_t)(pos0 - LC + (t >> 4) + 32 * (ib4 + i4)) * 32 + (d0 >> 1)) * 2;
        rc[i4][0] = *(const f32x4*)cs; rc[i4][1] = *(const f32x4*)(cs + 4);
      }
    }
#pragma unroll
    for (int i4 = 0; i4 < 4; ++i4) {
      const int itr = ib4 + i4;
      int rr = (t >> 4) + 32 * itr; float v[8];
      lds_row8(smem, rr, cg8, v);
      if (isC) {
        float ss = 0.f;
#pragma unroll
        for (int q = 0; q < 8; ++q) ss += v[q] * v[q];
        ss += __shfl_xor(ss, 1); ss += __shfl_xor(ss, 2); ss += __shfl_xor(ss, 4);
        float rstd = rsqrtf(ss * (1.f / 64.f) + EPS);
#pragma unroll
        for (int q = 0; q < 8; ++q) v[q] = v[q] * rstd * gnv[q];
      }
      if (latent) {
        const f32x4 c01 = rc[i4][0], c23 = rc[i4][1];
        float x1, x2;
        x1 = v[0]; x2 = v[1]; v[0] = x1 * c01[0] - x2 * c01[1]; v[1] = x1 * c01[1] + x2 * c01[0];
        x1 = v[2]; x2 = v[3]; v[2] = x1 * c01[2] - x2 * c01[3]; v[3] = x1 * c01[3] + x2 * c01[2];
        x1 = v[4]; x2 = v[5]; v[4] = x1 * c23[0] - x2 * c23[1]; v[5] = x1 * c23[1] + x2 * c23[0];
        x1 = v[6]; x2 = v[7]; v[6] = x1 * c23[2] - x2 * c23[3]; v[7] = x1 * c23[3] + x2 * c23[2];
      }
#pragma unroll
      for (int q = 0; q < 8; ++q) v[q] *= qs;
      store8bf(dst + (size_t)(row0 + rr) * ldd + coff + cg8 * 8, v);
    }
    }
  }
}
DI void inproj_tile(const Params& p, int l, int mt, int nt2, unsigned char* smem) {
  f32x4 acc[8][4];
  const us* H = (const us*)(p.ws + OFF_H);
  const us* Wt = (const us*)p.ws + W_WIN + (size_t)nt2 * 256 * 1024;
  gemm_tile16<2>(acc, H + (size_t)mt * 256 * 1024, 1024, 0, 256, Wt, 1024, 1024, smem);
#pragma unroll
  for (int half = 0; half < 2; ++half) {
    const int nt = nt2 * 2 + half;
    if (nt < 25) {
      acc_to_lds16<2>(acc, half, smem);
      __syncthreads();
      inproj_epi(p, l, mt * 256, nt, smem);
      __syncthreads();
    }
  }
}

DI void inproj_tile_dt(const Params& p, int l, int mt, unsigned char* smem) {
  f32x4 acc[8][2];
  const us* H = (const us*)(p.ws + OFF_H);
  const us* Wt = (const us*)p.ws + W_WIN + (size_t)24 * 128 * 1024;
  gemm_tile16<1>(acc, H + (size_t)mt * 256 * 1024, 1024, 0, 256, Wt, 1024, 1024, smem);
  acc_to_lds16<1>(acc, 0, smem);
  __syncthreads();
  inproj_epi(p, l, mt * 256, 24, smem);
  __syncthreads();
}

DI void conv_item(const Params& p, int l, int it, unsigned char* smem) {
  const int cb = it % 24, rest = it / 24, pb = rest % 34, b = rest / 34;
  const int t = tidx(), ch = t & 63, pg = t >> 6;
  const int c = cb * 64 + ch, p0 = pb * 128 + pg * 16;
  const int seg_lo = (pb < 2) ? 0 : LC, seg_hi = (pb < 2) ? LC : POS;
  us* tl = (us*)smem;
  {
    const us* X = (const us*)(p.ws + OFF_XBCRAW) + (size_t)b * POS * 1536 + cb * 64;
    for (int cidx = t; cidx < 130 * 8; cidx += NTHR) {
      const int rw = cidx >> 3, c8 = cidx & 7, ps = pb * 128 - 1 + rw;
      u32x4 v; v[0] = 0; v[1] = 0; v[2] = 0; v[3] = 0;
      if (ps >= seg_lo && ps < seg_hi) v = *(const u32x4*)(X + (size_t)ps * 1536 + c8 * 8);
      *(u32x4*)(tl + rw * 72 + c8 * 8) = v;
    }
  }
  __syncthreads();
  const float w0 = p.ssm_conv_w[(l * 3 + 0) * 1536 + c], w1 = p.ssm_conv_w[(l * 3 + 1) * 1536 + c], w2 = p.ssm_conv_w[(l * 3 + 2) * 1536 + c];
  const float bias = p.ssm_conv_b[l * 1536 + c];
  float raw[18];
#pragma unroll
  for (int i = 0; i < 18; ++i) raw[i] = bf2f(tl[(pg * 16 + i) * 72 + ch]);
  float o[16];
#pragma unroll
  for (int i = 0; i < 16; ++i) o[i] = silu(bias + w0 * raw[i] + w1 * raw[i + 1] + w2 * raw[i + 2]);
  if (c < 1024) {
    us* XT = (us*)(p.ws + OFF_XT) + ((size_t)(b * 1024 + c)) * POS + p0;
    float v[8], u[8];
#pragma unroll
    for (int q = 0; q < 8; ++q) { v[q] = o[q]; u[q] = o[8 + q]; }
    store8bf(XT, v); store8bf(XT + 8, u);
  } else if (c < 1280) {
    us* BN = (us*)(p.ws + OFF_BN) + ((size_t)(b * POS + p0)) * 256 + (c - 1024);
#pragma unroll
    for (int i = 0; i < 16; ++i) BN[(size_t)i * 256] = f2bf(o[i]);
    us* BT = (us*)(p.ws + OFF_BT) + ((size_t)(b * 256 + c - 1024)) * POS + p0;
    float v[8], u[8];
#pragma unroll
    for (int q = 0; q < 8; ++q) { v[q] = o[q]; u[q] = o[8 + q]; }
    store8bf(BT, v); store8bf(BT + 8, u);
  } else {
    us* CN = (us*)(p.ws + OFF_CN) + ((size_t)(b * POS + p0)) * 256 + (c - 1280);
#pragma unroll
    for (int i = 0; i < 16; ++i) CN[(size_t)i * 256] = f2bf(o[i]);
  }
  __syncthreads();
}

DI void attn_item(const us* Q, const us* Kp, const us* VT, us* O, int b, int head, int q0, int mode, int ntl_dense, bool has_sink, float sink, unsigned char* smem) {
  const int t = tidx(), lane = t & 63, w = t >> 6, r = lane & 31, h = lane >> 5;
  const int kvh = head >> 2;
  const int qpos = q0 + w * 32 + r;
  const int qwlo = q0 + w * 32 - 128, qwhi = q0 + w * 32 + 31 + 128;
  const size_t qrow = (size_t)b * POS + qpos;
  b16x8 qf[4];
#pragma unroll
  for (int s = 0; s < 4; ++s) qf[s] = __builtin_bit_cast(b16x8, *(const u32x4*)(Q + qrow * 512 + head * 64 + 16 * s + 8 * h));
  int lo = 0, ntl = ntl_dense;
  if (mode == 1) { lo = (q0 - 128) / 64; if (lo < 4) lo = 4; int hi = (q0 + 255 + 128) / 64; if (hi > 67) hi = 67; ntl = 4 + (hi - lo + 1); }
  f32x16 o0 = fzero(), o1 = fzero();
  float m = -1e30f, lsum = 0.f;
  const us* Kb = Kp + (size_t)b * POS * 128 + kvh * 64;
  const us* Vb = VT + ((size_t)(b * 128 + kvh * 64)) * POS;
  u32x4 pk_, pv_, qk_, qv_;
  const int lrw = t >> 3, lch = t & 7;
  auto tid = [&](int i) { return (mode == 1 && i >= 4) ? lo + (i - 4) : i; };
  auto gl = [&](u32x4& rk, u32x4& rv, int i) {
    const int tile = tid(i);
    rk = *(const u32x4*)(Kb + (size_t)(tile * 64 + lrw) * 128 + lch * 8);
    rv = *(const u32x4*)(Vb + (size_t)lrw * POS + tile * 64 + lch * 8);
  };
  auto ls = [&](const u32x4& rk, const u32x4& rv, int st) {
    unsigned char* Kd = smem + st * 18432 + lrw * 144 + lch * 16;
    *(u32x4*)Kd = rk; *(u32x4*)(Kd + 9216) = rv;
  };
  auto compute = [&](int st, int it) {
    const int kbase = tid(it) * 64;
    if (mode == 1 && it >= 4 && (kbase > qwhi || kbase + 63 < qwlo)) return;
    const unsigned char* Ks = smem + st * 18432; const unsigned char* Vs = Ks + 9216;
    f32x16 s0 = fzero(), s1 = fzero();
#pragma unroll
    for (int s = 0; s < 4; ++s) {
      b16x8 k0 = ldsfrag(Ks + r * 144 + (16 * s + 8 * h) * 2);
      b16x8 k1 = ldsfrag(Ks + (32 + r) * 144 + (16 * s + 8 * h) * 2);
      s0 = mfma(k0, qf[s], s0); s1 = mfma(k1, qf[s], s1);
    }
    if (mode == 1 && it >= 4) {
#pragma unroll
      for (int i = 0; i < 16; ++i) {
        int d0 = qpos - (kbase + crow(i, h)); int d1 = d0 - 32;
        if (d0 > 128 || d0 < -128) s0[i] = -1e30f;
        if (d1 > 128 || d1 < -128) s1[i] = -1e30f;
      }
    }
    float mx = s0[0];
#pragma unroll
    for (int i = 1; i < 16; ++i) mx = fmaxf(mx, s0[i]);
#pragma unroll
    for (int i = 0; i < 16; ++i) mx = fmaxf(mx, s1[i]);
    mx = fmaxf(mx, __shfl_xor(mx, 32));
    const float mn = fmaxf(m, mx);
    const float alpha = __builtin_amdgcn_exp2f(m - mn);
    m = mn;
    float ps = 0.f;
#pragma unroll
    for (int i = 0; i < 16; ++i) { s0[i] = __builtin_amdgcn_exp2f(s0[i] - mn); ps += s0[i]; s1[i] = __builtin_amdgcn_exp2f(s1[i] - mn); ps += s1[i]; }
    lsum = lsum * alpha + ps;
#pragma unroll
    for (int i = 0; i < 16; ++i) { o0[i] *= alpha; o1[i] *= alpha; }
    b16x8 pf[4];
    {
      u32x4 v;
      v[0] = pk2(s0[0], s0[1]); v[1] = pk2(s0[2], s0[3]); v[2] = pk2(s0[4], s0[5]); v[3] = pk2(s0[6], s0[7]); pf[0] = __builtin_bit_cast(b16x8, v);
      v[0] = pk2(s0[8], s0[9]); v[1] = pk2(s0[10], s0[11]); v[2] = pk2(s0[12], s0[13]); v[3] = pk2(s0[14], s0[15]); pf[1] = __builtin_bit_cast(b16x8, v);
      v[0] = pk2(s1[0], s1[1]); v[1] = pk2(s1[2], s1[3]); v[2] = pk2(s1[4], s1[5]); v[3] = pk2(s1[6], s1[7]); pf[2] = __builtin_bit_cast(b16x8, v);
      v[0] = pk2(s1[8], s1[9]); v[1] = pk2(s1[10], s1[11]); v[2] = pk2(s1[12], s1[13]); v[3] = pk2(s1[14], s1[15]); pf[3] = __builtin_bit_cast(b16x8, v);
    }
#pragma unroll
    for (int ks = 0; ks < 4; ++ks) {
      const unsigned char* v0 = Vs + r * 144 + (16 * ks + 4 * h) * 2;
      const unsigned char* v1 = Vs + (32 + r) * 144 + (16 * ks + 4 * h) * 2;
      o0 = mfma(ldsfrag2(v0, v0 + 16), pf[ks], o0);
      o1 = mfma(ldsfrag2(v1, v1 + 16), pf[ks], o1);
    }
  };
  __syncthreads();
  gl(pk_, pv_, 0);
  if (ntl > 1) gl(qk_, qv_, 1);
  ls(pk_, pv_, 0);
  if (ntl > 2) gl(pk_, pv_, 2);
  __syncthreads();
  for (int it = 0; it < ntl; it += 2) {
    if (it + 1 < ntl) ls(qk_, qv_, 1);
    if (it + 3 < ntl) gl(qk_, qv_, it + 3);
    compute(0, it);
    __syncthreads();
    if (it + 1 < ntl) {
      if (it + 2 < ntl) ls(pk_, pv_, 0);
      if (it + 4 < ntl) gl(pk_, pv_, it + 4);
      compute(1, it + 1);
      __syncthreads();
    }
  }
  float lt = lsum + __shfl_xor(lsum, 32);
  if (has_sink) lt += __builtin_amdgcn_exp2f(sink * LOG2E - m);
  const float inv = 1.f / lt;
  us* Op = O + qrow * 512 + head * 64;
#pragma unroll
  for (int q = 0; q < 4; ++q) {
    u32x2 a, c2;
    a[0] = pk2(o0[4 * q] * inv, o0[4 * q + 1] * inv); a[1] = pk2(o0[4 * q + 2] * inv, o0[4 * q + 3] * inv);
    c2[0] = pk2(o1[4 * q] * inv, o1[4 * q + 1] * inv); c2[1] = pk2(o1[4 * q + 2] * inv, o1[4 * q + 3] * inv);
    *(u32x2*)(Op + 8 * q + 4 * h) = a;
    *(u32x2*)(Op + 32 + 8 * q + 4 * h) = c2;
  }
  __syncthreads();
}

constexpr int SSD_HALF = 62976;
DI void ssd_item(const Params& p, int l, int b, int hd, int seg, unsigned char* smem0) {
  const int tt = tidx(), dir = tt >> 8, t = tt & 255, lane = t & 63, w = t >> 6, r = lane & 31, h = lane >> 5;
  unsigned char* smem = smem0 + dir * SSD_HALF;
  const int g = hd >> 3, ib = w & 1, pb = w >> 1;
  const bool fwd = dir == 0;
  unsigned char* Cs = smem;
  unsigned char* Bs = smem + 17408;
  unsigned char* Hs = smem + 34816;
  unsigned char* Xs = smem + 52224;
  float* dtv = (float*)(smem + 61440);
  float* acs = dtv + 64;
  const float a_coef = -expf(p.ssm_A_log[l * 32 + dir * 16 + hd]);
  const float Dsk = p.ssm_D[l * 16 + hd];
  const us* CN = (const us*)(p.ws + OFF_CN) + (size_t)b * POS * 256 + g * 128;
  const us* BN = (const us*)(p.ws + OFF_BN) + (size_t)b * POS * 256 + g * 128;
  const us* BT = (const us*)(p.ws + OFF_BT) + ((size_t)(b * 256 + g * 128 + w * 32 + r)) * POS;
  const us* XT = (const us*)(p.ws + OFF_XT) + ((size_t)(b * 1024 + hd * 64)) * POS;
  const float* DT = (const float*)(p.ws + OFF_DT) + (size_t)b * POS * 32 + dir * 16 + hd;
  us* Y = (us*)(p.ws + (fwd ? OFF_YF : OFF_YB)) + (size_t)b * POS * 1024 + hd * 64;
  f32x16 hT0 = fzero(), hT1 = fzero();
  u32x4 nc[4], nbv[4], nx[2]; float ndt = 0.f;
  auto chunk_of = [&](int ci) { return fwd ? ci : (ci < 4 ? 3 - ci : 71 - ci); };
  auto prefetch = [&](int ci) {
    const int p0 = chunk_of(ci) * 64;
#pragma unroll
    for (int i = 0; i < 4; ++i) {
      int c = t + 256 * i, rw = c >> 4, chn = c & 15;
      nc[i] = *(const u32x4*)(CN + (size_t)(p0 + rw) * 256 + chn * 8);
      nbv[i] = *(const u32x4*)(BN + (size_t)(p0 + rw) * 256 + chn * 8);
    }
#pragma unroll
    for (int i = 0; i < 2; ++i) {
      int c = t + 256 * i, rw = c >> 3, chn = c & 7;
      nx[i] = *(const u32x4*)(XT + (size_t)rw * POS + p0 + chn * 8);
    }
    if (w == 0) { const int ln_ = tidx() & 63; ndt = DT[(size_t)(p0 + ln_) * 32]; }
  };
  const int ci0 = seg * 34, ci1 = ci0 + 34;
  __syncthreads();
  if (t == 0) acs[64] = 0.f;
  prefetch(ci0);
  for (int ci = ci0; ci < ci1; ++ci) {
    const int chunk = chunk_of(ci);
    const int pos0 = chunk * 64;
#pragma unroll
    for (int i = 0; i < 4; ++i) {
      int c = t + 256 * i, rw = c >> 4, chn = c & 15;
      *(u32x4*)(Cs + rw * 272 + chn * 16) = nc[i];
      *(u32x4*)(Bs + rw * 272 + chn * 16) = nbv[i];
    }
#pragma unroll
    for (int i = 0; i < 2; ++i) {
      int c = t + 256 * i, rw = c >> 3, chn = c & 7;
      *(u32x4*)(Xs + rw * 144 + chn * 16) = nx[i];
    }
    if (w == 0) {
      float d = ndt;
      float a = d * a_coef;
      if (fwd) {
#pragma unroll
        for (int o = 1; o < 64; o <<= 1) { float n = __shfl_up(a, o); if (lane >= o) a += n; }
      } else {
#pragma unroll
        for (int o = 1; o < 64; o <<= 1) { float n = __shfl_down(a, o); if (lane + o < 64) a += n; }
      }
      dtv[lane] = d; acs[lane] = a;
      acs[72 + lane] = d * __expf(__shfl(a, fwd ? 63 : 0) - a);
      if (seg == 1) {
        const float tot_ = __shfl(a, fwd ? 63 : 0);
        if (lane == 0) { const int d_ = tidx() >> 8; const float cum = acs[64]; ((float*)(p.ws + OFF_CUMP))[((b * 2 + d_) * 16 + hd) * 34 + (ci - 34)] = cum; acs[64] = cum + tot_; }
      }
    }
#pragma unroll
    for (int q = 0; q < 4; ++q) {
      u32x2 a, c2;
      a[0] = pk2(hT0[4 * q], hT0[4 * q + 1]); a[1] = pk2(hT0[4 * q + 2], hT0[4 * q + 3]);
      c2[0] = pk2(hT1[4 * q], hT1[4 * q + 1]); c2[1] = pk2(hT1[4 * q + 2], hT1[4 * q + 3]);
      *(u32x2*)(Hs + r * 272 + (w * 32 + 8 * q + 4 * h) * 2) = a;
      *(u32x2*)(Hs + (32 + r) * 272 + (w * 32 + 8 * q + 4 * h) * 2) = c2;
    }
    __syncthreads();
    if (ci + 1 < ci1) prefetch(ci + 1);
    const int iloc = ib * 32 + r;
    const float acs_i = acs[iloc];
    f32x16 yo;
    {
      f32x16 y0 = fzero(), y1 = fzero();
#pragma unroll
      for (int s4 = 0; s4 < 8; s4 += 4) {
        b16x8 hf[4], cf[4];
#pragma unroll
        for (int s = 0; s < 4; ++s) { hf[s] = ldsfrag(Hs + (pb * 32 + r) * 272 + (16 * (s4 + s) + 8 * h) * 2); cf[s] = ldsfrag(Cs + iloc * 272 + (16 * (s4 + s) + 8 * h) * 2); }
        y0 = mfma(hf[0], cf[0], y0); y1 = mfma(hf[1], cf[1], y1); y0 = mfma(hf[2], cf[2], y0); y1 = mfma(hf[3], cf[3], y1);
      }
#pragma unroll
      for (int i = 0; i < 16; ++i) yo[i] = y0[i] + y1[i];
    }
    b16x8 wf[4];
#pragma unroll
    for (int jb = 0; jb < 2; ++jb) {
      const bool act = fwd ? (jb <= ib) : (jb >= ib);
      u32x4 f0, f1;
      f0[0] = 0; f0[1] = 0; f0[2] = 0; f0[3] = 0; f1 = f0;
      if (act) {
        f32x16 g0 = fzero(), g1 = fzero();
#pragma unroll
        for (int s4 = 0; s4 < 8; s4 += 4) {
          b16x8 bfg[4], cf[4];
#pragma unroll
          for (int s = 0; s < 4; ++s) { bfg[s] = ldsfrag(Bs + (jb * 32 + r) * 272 + (16 * (s4 + s) + 8 * h) * 2); cf[s] = ldsfrag(Cs + iloc * 272 + (16 * (s4 + s) + 8 * h) * 2); }
          g0 = mfma(bfg[0], cf[0], g0); g1 = mfma(bfg[1], cf[1], g1); g0 = mfma(bfg[2], cf[2], g0); g1 = mfma(bfg[3], cf[3], g1);
        }
        float wv[16];
#pragma unroll
        for (int q4 = 0; q4 < 4; ++q4) {
          const int j0 = jb * 32 + 8 * q4 + 4 * h;
          const f32x4 aj = *(const f32x4*)(acs + j0), dj = *(const f32x4*)(dtv + j0);
#pragma unroll
          for (int e4 = 0; e4 < 4; ++e4) {
            const int i = 4 * q4 + e4, j = j0 + e4;
            bool valid = fwd ? (j <= iloc) : (j >= iloc);
            float e = valid ? __expf(acs_i - aj[e4]) * dj[e4] : 0.f;
            wv[i] = (g0[i] + g1[i]) * e;
          }
        }
        f0[0] = pk2(wv[0], wv[1]); f0[1] = pk2(wv[2], wv[3]); f0[2] = pk2(wv[4], wv[5]); f0[3] = pk2(wv[6], wv[7]);
        f1[0] = pk2(wv[8], wv[9]); f1[1] = pk2(wv[10], wv[11]); f1[2] = pk2(wv[12], wv[13]); f1[3] = pk2(wv[14], wv[15]);
      }
      wf[jb * 2] = __builtin_bit_cast(b16x8, f0); wf[jb * 2 + 1] = __builtin_bit_cast(b16x8, f1);
    }
    u32x4 btf[4];
#pragma unroll
    for (int s = 0; s < 4; ++s) btf[s] = *(const u32x4*)(BT + pos0 + 16 * s + 8 * h);
    f32x16 yd = fzero();
    {
      b16x8 xf[4];
#pragma unroll
      for (int ks = 0; ks < 4; ++ks) { const unsigned char* xp = Xs + (pb * 32 + r) * 144 + (16 * ks + 4 * h) * 2; xf[ks] = ldsfrag2(xp, xp + 16); }
#pragma unroll
      for (int ks = 0; ks < 4; ++ks) yd = mfma(xf[ks], wf[ks], yd);
    }
    {
      const float ei = __expf(acs_i);
      us* yp = Y + (size_t)(pos0 + iloc) * 1024 + pb * 32;
#pragma unroll
      for (int q = 0; q < 4; ++q) {
        float v[4];
#pragma unroll
        for (int e = 0; e < 4; ++e) {
          int i = 4 * q + e;
          float val = yd[i] + ei * yo[i];
          if (fwd) val += Dsk * bf2f(*(const us*)(Xs + (pb * 32 + crow(i, h)) * 144 + iloc * 2));
          v[e] = val;
        }
        u32x2 o; o[0] = pk2(v[0], v[1]); o[1] = pk2(v[2], v[3]);
        *(u32x2*)(yp + 8 * q + 4 * h) = o;
      }
    }
    {
      const float tot = fwd ? acs[63] : acs[0];
      const float dec = __expf(tot);
#pragma unroll
      for (int i = 0; i < 16; ++i) { hT0[i] *= dec; hT1[i] *= dec; }
#pragma unroll
      for (int s = 0; s < 4; ++s) {
        u32x4 xv[1][2];
#pragma unroll
        for (int pbb = 0; pbb < 2; ++pbb) xv[0][pbb] = *(const u32x4*)(Xs + (pbb * 32 + r) * 144 + (16 * s + 8 * h) * 2);
        float wj[8];
        { const f32x4 w0 = *(const f32x4*)(acs + 72 + 16 * s + 8 * h), w1 = *(const f32x4*)(acs + 72 + 16 * s + 8 * h + 4);
          wj[0] = w0[0]; wj[1] = w0[1]; wj[2] = w0[2]; wj[3] = w0[3]; wj[4] = w1[0]; wj[5] = w1[1]; wj[6] = w1[2]; wj[7] = w1[3]; }
        b16x8 af = __builtin_bit_cast(b16x8, btf[s]);
#pragma unroll
        for (int pbb = 0; pbb < 2; ++pbb) {
          const u32x4 x4 = xv[0][pbb];
          u32x4 sv;
          sv[0] = pk2(bflo(x4[0]) * wj[0], bfhi(x4[0]) * wj[1]); sv[1] = pk2(bflo(x4[1]) * wj[2], bfhi(x4[1]) * wj[3]);
          sv[2] = pk2(bflo(x4[2]) * wj[4], bfhi(x4[2]) * wj[5]); sv[3] = pk2(bflo(x4[3]) * wj[6], bfhi(x4[3]) * wj[7]);
          if (pbb == 0) hT0 = mfma(af, __builtin_bit_cast(b16x8, sv), hT0);
          else hT1 = mfma(af, __builtin_bit_cast(b16x8, sv), hT1);
        }
      }
    }
    __syncthreads();
  }
  if (seg == 0) {
    const int t3 = tidx(), d3 = t3 >> 8, w3 = (t3 >> 6) & 3, r3 = t3 & 31, h3 = (t3 >> 5) & 1;
    us* HM = (us*)(p.ws + OFF_HMID) + (size_t)((b * 2 + d3) * 16 + hd) * 8192;
#pragma unroll
    for (int q = 0; q < 4; ++q) {
      u32x2 a, c2;
      a[0] = pk2(hT0[4 * q], hT0[4 * q + 1]); a[1] = pk2(hT0[4 * q + 2], hT0[4 * q + 3]);
      c2[0] = pk2(hT1[4 * q], hT1[4 * q + 1]); c2[1] = pk2(hT1[4 * q + 2], hT1[4 * q + 3]);
      *(u32x2*)(HM + r3 * 128 + w3 * 32 + 8 * q + 4 * h3) = a;
      *(u32x2*)(HM + (32 + r3) * 128 + w3 * 32 + 8 * q + 4 * h3) = c2;
    }
  }
}

DI void ssd_fix_item(const Params& p, int l, int it) {
  const int tt = tidx(), hh = tt >> 8, t = tt & 255, lane = t & 63, w = t >> 6, r = lane & 31, h = lane >> 5;
  const int sidx = it / 17, pair = it - sidx * 17;
  const int b = sidx >> 5, dir = (sidx >> 4) & 1, hd = sidx & 15, g = hd >> 3, ib = w & 1, pb = w >> 1;
  const bool fwd = dir == 0;
  const int cl = pair * 2 + hh, ci = 34 + cl;
  const int chunk = fwd ? ci : 71 - ci, pos0 = chunk * 64;
  const float a_coef = -expf(p.ssm_A_log[l * 32 + dir * 16 + hd]);
  float a = ((const float*)(p.ws + OFF_DT))[((size_t)b * POS + pos0 + lane) * 32 + dir * 16 + hd] * a_coef;
  if (fwd) {
#pragma unroll
    for (int o = 1; o < 64; o <<= 1) { float n = __shfl_up(a, o); if (lane >= o) a += n; }
  } else {
#pragma unroll
    for (int o = 1; o < 64; o <<= 1) { float n = __shfl_down(a, o); if (lane + o < 64) a += n; }
  }
  const int iloc = ib * 32 + r;
  const float acs_i = __shfl(a, iloc);
  const float e = __expf(((const float*)(p.ws + OFF_CUMP))[sidx * 34 + cl] + acs_i);
  const us* HM = (const us*)(p.ws + OFF_HMID) + (size_t)sidx * 8192 + (pb * 32 + r) * 128 + 8 * h;
  const us* CNp = (const us*)(p.ws + OFF_CN) + ((size_t)b * POS + pos0 + iloc) * 256 + g * 128 + 8 * h;
  f32x16 y0 = fzero(), y1 = fzero();
#pragma unroll
  for (int s4 = 0; s4 < 8; s4 += 4) {
    u32x4 hf[4], cf[4];
#pragma unroll
    for (int s = 0; s < 4; ++s) { hf[s] = *(const u32x4*)(HM + 16 * (s4 + s)); cf[s] = *(const u32x4*)(CNp + 16 * (s4 + s)); }
    y0 = mfma(__builtin_bit_cast(b16x8, hf[0]), __builtin_bit_cast(b16x8, cf[0]), y0); y1 = mfma(__builtin_bit_cast(b16x8, hf[1]), __builtin_bit_cast(b16x8, cf[1]), y1);
    y0 = mfma(__builtin_bit_cast(b16x8, hf[2]), __builtin_bit_cast(b16x8, cf[2]), y0); y1 = mfma(__builtin_bit_cast(b16x8, hf[3]), __builtin_bit_cast(b16x8, cf[3]), y1);
  }
  us* yp = (us*)(p.ws + (fwd ? OFF_YF : OFF_YB)) + ((size_t)b * POS + pos0 + iloc) * 1024 + hd * 64 + pb * 32;
#pragma unroll
  for (int q = 0; q < 4; ++q) {
    u32x2 o = *(const u32x2*)(yp + 8 * q + 4 * h);
    float v0 = bflo(o[0]) + e * (y0[4 * q] + y1[4 * q]), v1 = bfhi(o[0]) + e * (y0[4 * q + 1] + y1[4 * q + 1]);
    float v2 = bflo(o[1]) + e * (y0[4 * q + 2] + y1[4 * q + 2]), v3 = bfhi(o[1]) + e * (y0[4 * q + 3] + y1[4 * q + 3]);
    o[0] = pk2(v0, v1); o[1] = pk2(v2, v3);
    *(u32x2*)(yp + 8 * q + 4 * h) = o;
  }
}

template <int MB>
DI void zgate_tile(const Params& p, int l, int row0, int nt, unsigned char* smem) {
  const us* H = (const us*)(p.ws + OFF_H);
  const us* Wt = (const us*)p.ws + W_WIN + (size_t)(3200 + nt * 128) * 1024;
  if constexpr (MB == 4) {
    f32x4 acc[8][2];
    gemm_tile16<1>(acc, H + (size_t)row0 * 1024, 1024, 0, 256, Wt, 1024, 1024, smem);
    acc_to_lds16<1>(acc, 0, smem);
  } else {
    f32x16 acc[MB][1];
    gemm_tile<1, MB>(acc, H + (size_t)row0 * 1024, 1024, 0, 64 * MB, Wt, 1024, 1024, smem);
    acc_to_lds<1, MB>(acc, 0, smem);
  }
  __syncthreads();
  const int t = tidx(), cg8 = t & 15;
  us* YF = (us*)(p.ws + OFF_YF); const us* YB = (const us*)(p.ws + OFF_YB);
  float* PART = (float*)(p.ws + OFF_PART);
  float gn[8];
#pragma unroll
  for (int q = 0; q < 8; ++q) gn[q] = p.ssm_norm[l * 1024 + nt * 128 + cg8 * 8 + q];
  u32x4 yfr[2 * MB], ybr[2 * MB];
#pragma unroll
  for (int itr = 0; itr < 2 * MB; ++itr) {
    size_t off = (size_t)(row0 + (t >> 4) + 32 * itr) * 1024 + nt * 128 + cg8 * 8;
    yfr[itr] = *(const u32x4*)(YF + off); ybr[itr] = *(const u32x4*)(YB + off);
  }
#pragma unroll
  for (int itr = 0; itr < 2 * MB; ++itr) {
    int rr = (t >> 4) + 32 * itr; float z[8], yf[8], yb[8], o[8];
    lds_row8(smem, rr, cg8, z);
    size_t off = (size_t)(row0 + rr) * 1024 + nt * 128 + cg8 * 8;
    { const u32x4 a = yfr[itr], b2 = ybr[itr];
      yf[0] = bflo(a[0]); yf[1] = bfhi(a[0]); yf[2] = bflo(a[1]); yf[3] = bfhi(a[1]); yf[4] = bflo(a[2]); yf[5] = bfhi(a[2]); yf[6] = bflo(a[3]); yf[7] = bfhi(a[3]);
      yb[0] = bflo(b2[0]); yb[1] = bfhi(b2[0]); yb[2] = bflo(b2[1]); yb[3] = bfhi(b2[1]); yb[4] = bflo(b2[2]); yb[5] = bfhi(b2[2]); yb[6] = bflo(b2[3]); yb[7] = bfhi(b2[3]); }
    float ss = 0.f;
#pragma unroll
    for (int q = 0; q < 8; ++q) { float v = (yf[q] + yb[q]) * silu(z[q]); ss += v * v; o[q] = v * gn[q]; }
    store8bf(YF + off, o);
    ss += __shfl_xor(ss, 1); ss += __shfl_xor(ss, 2); ss += __shfl_xor(ss, 4); ss += __shfl_xor(ss, 8);
    if (cg8 == 0) PART[(size_t)(row0 + rr) * 8 + nt] = ss;
  }
  __syncthreads();
}

DI void zgate_tile_w(const Params& p, int l, int row0, int ntw, unsigned char* smem) {
  const us* H = (const us*)(p.ws + OFF_H);
  const us* Wt = (const us*)p.ws + W_WIN + (size_t)(3200 + ntw * 256) * 1024;
  f32x4 acc[8][4];
  gemm_tile16<2>(acc, H + (size_t)row0 * 1024, 1024, 0, 256, Wt, 1024, 1024, smem);
#pragma unroll
  for (int half = 0; half < 2; ++half) {
    const int nt = ntw * 2 + half;
    acc_to_lds16<2>(acc, half, smem);
    __syncthreads();
  const int t = tidx(), cg8 = t & 15;
  us* YF = (us*)(p.ws + OFF_YF); const us* YB = (const us*)(p.ws + OFF_YB);
  float* PART = (float*)(p.ws + OFF_PART);
  float gn[8];
#pragma unroll
  for (int q = 0; q < 8; ++q) gn[q] = p.ssm_norm[l * 1024 + nt * 128 + cg8 * 8 + q];
  u32x4 yfr[8], ybr[8];
#pragma unroll
  for (int itr = 0; itr < 8; ++itr) {
    size_t off = (size_t)(row0 + (t >> 4) + 32 * itr) * 1024 + nt * 128 + cg8 * 8;
    yfr[itr] = *(const u32x4*)(YF + off); ybr[itr] = *(const u32x4*)(YB + off);
  }
#pragma unroll
  for (int itr = 0; itr < 8; ++itr) {
    int rr = (t >> 4) + 32 * itr; float z[8], yf[8], yb[8], o[8];
    lds_row8(smem, rr, cg8, z);
    size_t off = (size_t)(row0 + rr) * 1024 + nt * 128 + cg8 * 8;
    { const u32x4 a = yfr[itr], b2 = ybr[itr];
      yf[0] = bflo(a[0]); yf[1] = bfhi(a[0]); yf[2] = bflo(a[1]); yf[3] = bfhi(a[1]); yf[4] = bflo(a[2]); yf[5] = bfhi(a[2]); yf[6] = bflo(a[3]); yf[7] = bfhi(a[3]);
      yb[0] = bflo(b2[0]); yb[1] = bfhi(b2[0]); yb[2] = bflo(b2[1]); yb[3] = bfhi(b2[1]); yb[4] = bflo(b2[2]); yb[5] = bfhi(b2[2]); yb[6] = bflo(b2[3]); yb[7] = bfhi(b2[3]); }
    float ss = 0.f;
#pragma unroll
    for (int q = 0; q < 8; ++q) { float v = (yf[q] + yb[q]) * silu(z[q]); ss += v * v; o[q] = v * gn[q]; }
    store8bf(YF + off, o);
    ss += __shfl_xor(ss, 1); ss += __shfl_xor(ss, 2); ss += __shfl_xor(ss, 4); ss += __shfl_xor(ss, 8);
    if (cg8 == 0) PART[(size_t)(row0 + rr) * 8 + nt] = ss;
  }
    __syncthreads();
  }
}

template <int MB>
DI void merge_tile(const Params& p, int l, int row0, int nt, unsigned char* smem) {
  const int t = tidx(), lane = t & 63, w = t >> 6, h = lane >> 5, wm = w >> 2;
  float* rs = (float*)(smem + LDS_MAIN);
  if (t < 64 * MB) {
    const float* pp = (const float*)(p.ws + OFF_PART) + (size_t)(row0 + t) * 8;
    float s = ((pp[0] + pp[1]) + (pp[2] + pp[3])) + ((pp[4] + pp[5]) + (pp[6] + pp[7]));
    rs[t] = rsqrtf(s * (1.f / 1024.f) + EPS);
  }
  const us* H = (const us*)(p.ws + OFF_H) + (size_t)row0 * 1024;
  const us* Wb = (const us*)p.ws;
  us* M = (us*)(p.ws + OFF_M);
#pragma unroll 1
  for (int br = 0; br < 3; ++br) {
    { int z_ = 0; asm volatile("" : "+v"(z_)); row0 += z_; }
    const us* Ya; const us* Wo; int K;
    if (br == 0) { Ya = (const us*)(p.ws + OFF_YA) + (size_t)row0 * 512; Wo = Wb + W_WOA + (size_t)nt * 128 * 512; K = 512; }
    else if (br == 1) { Ya = (const us*)(p.ws + OFF_YF) + (size_t)row0 * 1024; Wo = Wb + W_WOB + (size_t)nt * 128 * 1024; K = 1024; }
    else { Ya = (const us*)(p.ws + OFF_YC) + (size_t)row0 * 512; Wo = Wb + W_WOC + (size_t)nt * 128 * 512; K = 512; }
    if constexpr (MB == 4) {
      unsigned gp[8][2][2];
      {
        f32x4 acc[8][2];
        gemm_tile16<1>(acc, H, 1024, 0, 256, Wb + W_WIN + (size_t)(4224 + br * 1024 + nt * 128) * 1024, 1024, 1024, smem);
#pragma unroll
        for (int i = 0; i < 8; ++i)
#pragma unroll
          for (int j = 0; j < 2; ++j) { gp[i][j][0] = pk2(sigmoidf(acc[i][j][0]), sigmoidf(acc[i][j][1])); gp[i][j][1] = pk2(sigmoidf(acc[i][j][2]), sigmoidf(acc[i][j][3])); }
      }
      f32x4 acc[8][2];
      gemm_tile16<1>(acc, Ya, K, 0, 256, Wo, K, K, smem);
      const int quad = lane >> 4;
#pragma unroll
      for (int i = 0; i < 8; ++i) {
        f32x4 sc4; sc4[0] = 1.f; sc4[1] = 1.f; sc4[2] = 1.f; sc4[3] = 1.f;
        if (br == 1) sc4 = *(const f32x4*)(rs + wm * 128 + i * 16 + quad * 4);
#pragma unroll
        for (int j = 0; j < 2; ++j) {
          acc[i][j][0] *= bflo(gp[i][j][0]) * sc4[0]; acc[i][j][1] *= bfhi(gp[i][j][0]) * sc4[1];
          acc[i][j][2] *= bflo(gp[i][j][1]) * sc4[2]; acc[i][j][3] *= bfhi(gp[i][j][1]) * sc4[3];
        }
      }
      acc_to_lds16<1>(acc, 0, smem);
    } else {
      unsigned gp[MB][8];
      {
        f32x16 acc[MB][1];
        gemm_tile<1, MB>(acc, H, 1024, 0, 64 * MB, Wb + W_WIN + (size_t)(4224 + br * 1024 + nt * 128) * 1024, 1024, 1024, smem);
#pragma unroll
        for (int i = 0; i < MB; ++i)
#pragma unroll
          for (int q = 0; q < 8; ++q) gp[i][q] = pk2(sigmoidf(acc[i][0][2 * q]), sigmoidf(acc[i][0][2 * q + 1]));
      }
      f32x16 acc[MB][1];
      gemm_tile<1, MB>(acc, Ya, K, 0, 64 * MB, Wo, K, K, smem);
#pragma unroll
      for (int i = 0; i < MB; ++i)
#pragma unroll
        for (int q = 0; q < 16; ++q) {
          float gv = (q & 1) ? bfhi(gp[i][q >> 1]) : bflo(gp[i][q >> 1]);
          float sc = (br == 1) ? rs[wm * 32 * MB + i * 32 + crow(q, h)] : 1.f;
          acc[i][0][q] *= gv * sc;
        }
      acc_to_lds<1, MB>(acc, 0, smem);
    }
    __syncthreads();
    const int t2 = tidx(), cg8 = t2 & 15;
    u32x4 pm[2 * MB];
    if (br > 0) {
#pragma unroll
      for (int itr = 0; itr < 2 * MB; ++itr) pm[itr] = *(const u32x4*)(M + (size_t)(row0 + (t2 >> 4) + 32 * itr) * 1024 + nt * 128 + cg8 * 8);
    }
#pragma unroll
    for (int itr = 0; itr < 2 * MB; ++itr) {
      int rr = (t2 >> 4) + 32 * itr; float v[8];
      lds_row8(smem, rr, cg8, v);
      us* mp = M + (size_t)(row0 + rr) * 1024 + nt * 128 + cg8 * 8;
      if (br > 0) {
        const u32x4 a = pm[itr];
        v[0] += bflo(a[0]); v[1] += bfhi(a[0]); v[2] += bflo(a[1]); v[3] += bfhi(a[1]); v[4] += bflo(a[2]); v[5] += bfhi(a[2]); v[6] += bflo(a[3]); v[7] += bfhi(a[3]);
      }
      store8bf(mp, v);
    }
    __syncthreads();
  }
}

template <int MB>
DI void resid_tile(const Params& p, int l, int row0, int nt, const us* A, int K, const us* Wt, int gate_off, bool src_in, unsigned char* smem) {
  if constexpr (MB == 4) {
    f32x4 acc[8][2];
    gemm_tile16<1>(acc, A + (size_t)row0 * K, K, 0, 256, Wt + (size_t)nt * 128 * K, K, K, smem);
    acc_to_lds16<1>(acc, 0, smem);
  } else {
    f32x16 acc[MB][1];
    gemm_tile<1, MB>(acc, A + (size_t)row0 * K, K, 0, 64 * MB, Wt + (size_t)nt * 128 * K, K, K, smem);
    acc_to_lds<1, MB>(acc, 0, smem);
  }
  __syncthreads();
  const int t = tidx(), cg8 = t & 15;
  const float* cm = cmod_row(p, l, row0) + gate_off + nt * 128 + cg8 * 8;
  f32x4 g0 = *(const f32x4*)cm, g1 = *(const f32x4*)(cm + 4);
  f32x4 xr0[2 * MB], xr1[2 * MB];
#pragma unroll
  for (int itr = 0; itr < 2 * MB; ++itr) {
    const float* xs = xrow_r(p, src_in, row0 + (t >> 4) + 32 * itr) + nt * 128 + cg8 * 8;
    xr0[itr] = *(const f32x4*)xs; xr1[itr] = *(const f32x4*)(xs + 4);
  }
#pragma unroll
  for (int itr = 0; itr < 2 * MB; ++itr) {
    int rr = (t >> 4) + 32 * itr; float v[8];
    lds_row8(smem, rr, cg8, v);
    float* xd = xrow_w(p, row0 + rr) + nt * 128 + cg8 * 8;
    f32x4 x0 = xr0[itr], x1 = xr1[itr], o0, o1;
    o0[0] = x0[0] + g0[0] * v[0]; o0[1] = x0[1] + g0[1] * v[1]; o0[2] = x0[2] + g0[2] * v[2]; o0[3] = x0[3] + g0[3] * v[3];
    o1[0] = x1[0] + g1[0] * v[4]; o1[1] = x1[1] + g1[1] * v[5]; o1[2] = x1[2] + g1[2] * v[6]; o1[3] = x1[3] + g1[3] * v[7];
    *(f32x4*)xd = o0; *(f32x4*)(xd + 4) = o1;
  }
  __syncthreads();
}

DI void resid_tile_w(const Params& p, int l, int row0, int ntw, const us* A, int K, const us* Wt, int gate_off, bool src_in, unsigned char* smem) {
  f32x4 acc[8][4];
  gemm_tile16<2>(acc, A + (size_t)row0 * K, K, 0, 256, Wt + (size_t)ntw * 256 * K, K, K, smem);
#pragma unroll
  for (int half = 0; half < 2; ++half) {
    const int nt = ntw * 2 + half;
    acc_to_lds16<2>(acc, half, smem);
    __syncthreads();
    const int t = tidx(), cg8 = t & 15;
    const float* cm = cmod_row(p, l, row0) + gate_off + nt * 128 + cg8 * 8;
    f32x4 g0 = *(const f32x4*)cm, g1 = *(const f32x4*)(cm + 4);
    f32x4 xr0[8], xr1[8];
#pragma unroll
    for (int itr = 0; itr < 8; ++itr) {
      const float* xs = xrow_r(p, src_in, row0 + (t >> 4) + 32 * itr) + nt * 128 + cg8 * 8;
      xr0[itr] = *(const f32x4*)xs; xr1[itr] = *(const f32x4*)(xs + 4);
    }
#pragma unroll
    for (int itr = 0; itr < 8; ++itr) {
      int rr = (t >> 4) + 32 * itr; float v[8];
      lds_row8(smem, rr, cg8, v);
      float* xd = xrow_w(p, row0 + rr) + nt * 128 + cg8 * 8;
      f32x4 x0 = xr0[itr], x1 = xr1[itr], o0, o1;
      o0[0] = x0[0] + g0[0] * v[0]; o0[1] = x0[1] + g0[1] * v[1]; o0[2] = x0[2] + g0[2] * v[2]; o0[3] = x0[3] + g0[3] * v[3];
      o1[0] = x1[0] + g1[0] * v[4]; o1[1] = x1[1] + g1[1] * v[5]; o1[2] = x1[2] + g1[2] * v[6]; o1[3] = x1[3] + g1[3] * v[7];
      *(f32x4*)xd = o0; *(f32x4*)(xd + 4) = o1;
    }
    __syncthreads();
  }
}

DI void ffn1_tile(const Params& p, int l, int ftile, int nt2, unsigned char* smem) {
  const int b = ftile / 19, q = ftile - b * 19;
  int seg_lo, seg_hi, idx;
  if (q < 2) { seg_lo = 0; seg_hi = LC; idx = q; } else { seg_lo = LC; seg_hi = POS; idx = q - 2; }
  const int s = seg_lo + idx * 254;
  int r_lo = (s - 1 < seg_lo) ? 1 : 0;
  int r_hi = seg_hi - (s - 1); if (r_hi > 256) r_hi = 256;
  const us* A = (const us*)(p.ws + OFF_H2) + ((long)b * POS + s - 1) * 1024;
  const us* Wt = (const us*)p.ws + W_WUG + (size_t)nt2 * 256 * 1024;
  f32x4 acc[8][4];
  gemm_tile16<2>(acc, A, 1024, r_lo, r_hi, Wt, 1024, 1024, smem);
  const float* Cs = (const float*)smem;
#pragma unroll
  for (int half = 0; half < 2; ++half) {
    acc_to_lds16<2>(acc, half, smem);
    __syncthreads();
    const int t = tidx(), cg = t & 7, rb = t >> 3;
    const int c = (nt2 * 2 + half) * 64 + cg * 8;
    float w0[8], w1[8], w2[8], bias[8];
#pragma unroll
    for (int q = 0; q < 8; ++q) {
      w0[q] = p.ffn_conv_w[(l * 3 + 0) * DFF + c + q]; w1[q] = p.ffn_conv_w[(l * 3 + 1) * DFF + c + q];
      w2[q] = p.ffn_conv_w[(l * 3 + 2) * DFF + c + q]; bias[q] = p.ffn_conv_b[l * DFF + c + q];
    }
    us* ACT = (us*)(p.ws + OFF_ACT) + ((size_t)b * POS) * DFF + c;
#pragma unroll
    for (int itr = 0; itr < 4; ++itr) {
      const int rr = 1 + rb + 64 * itr;
      const int pos = s - 1 + rr;
      if (rr <= 254 && pos < seg_hi) {
        float gm[8], g0[8], gp[8], up[8], o[8];
        lds_row8(smem, rr - 1, cg, gm); lds_row8(smem, rr, cg, g0); lds_row8(smem, rr + 1, cg, gp); lds_row8(smem, rr, 8 + cg, up);
        const bool hasm = pos - 1 >= seg_lo, hasp = pos + 1 < seg_hi;
#pragma unroll
        for (int q = 0; q < 8; ++q) o[q] = silu(bias[q] + (hasm ? w0[q] * gm[q] : 0.f) + w1[q] * g0[q] + (hasp ? w2[q] * gp[q] : 0.f)) * up[q];
        store8bf(ACT + (size_t)pos * DFF, o);
      }
    }
    __syncthreads();
  }
}

DI void final_item(const Params& p, int it) {
  const int lane = tidx() & 63, w = tidx() >> 6;
  const int row = it * 8 + w;
  float* xr = p.out + (size_t)row * DM;
  f32x4 v[4]; float ss = 0.f;
#pragma unroll
  for (int i = 0; i < 4; ++i) { v[i] = *(const f32x4*)(xr + i * 256 + lane * 4); ss += v[i][0] * v[i][0] + v[i][1] * v[i][1] + v[i][2] * v[i][2] + v[i][3] * v[i][3]; }
#pragma unroll
  for (int o = 32; o > 0; o >>= 1) ss += __shfl_xor(ss, o);
  const float rstd = rsqrtf(ss * (1.f / DM) + EPS);
#pragma unroll
  for (int i = 0; i < 4; ++i) {
    f32x4 gg = *(const f32x4*)(p.final_norm + i * 256 + lane * 4), o;
    o[0] = v[i][0] * rstd * gg[0]; o[1] = v[i][1] * rstd * gg[1]; o[2] = v[i][2] * rstd * gg[2]; o[3] = v[i][3] * rstd * gg[3];
    *(f32x4*)(xr + i * 256 + lane * 4) = o;
  }
}

DI void mixer_item(const Params& p, int l, int it, unsigned char* smem) {
  if (it < 128) { ssd_item(p, l, it >> 5, (it >> 1) & 15, it & 1, smem); return; }
  it -= 128;
  const us* QA = (const us*)(p.ws + OFF_QA); const us* QC = (const us*)(p.ws + OFF_QC);
  const us* KA = (const us*)(p.ws + OFF_KA); const us* KC = (const us*)(p.ws + OFF_KC);
  const us* VAT = (const us*)(p.ws + OFF_VAT); const us* VCT = (const us*)(p.ws + OFF_VCT);
  us* YA = (us*)(p.ws + OFF_YA); us* YC = (us*)(p.ws + OFF_YC);
  if (it < 512) { int qb = it & 15, head = (it >> 4) & 7, b = it >> 7; attn_item(QC, KC, VCT, YC, b, head, LC + qb * 256, 0, 68, false, 0.f, smem); return; }
  it -= 512;
  if (it < 512) { int qb = it & 15, head = (it >> 4) & 7, b = it >> 7; attn_item(QA, KA, VAT, YA, b, head, LC + qb * 256, 1, 0, true, p.a_sink[l * 8 + head], smem); return; }
  it -= 512;
  if (it < 32) { int head = it & 7, b = it >> 3; attn_item(QC, KC, VCT, YC, b, head, 0, 0, 4, false, 0.f, smem); return; }
  it -= 32;
  { int head = it & 7, b = it >> 3; attn_item(QA, KA, VAT, YA, b, head, 0, 0, 4, true, p.a_sink[l * 8 + head], smem); }
}

#define XB_TMO      128
#define XB_XCNT(j)  (256  + 64 * (j))
#define XB_XSUB(j)  (1280 + 64 * (j))
#define XB_XGEN(j)  (2304 + 64 * (j))
#define XB_TOP      3328
#define XB_TOPGEN   3392
#define XCD_BAR_WORDS 3456
#define XB_SPIN_CAP (1u << 20)
DI unsigned xb_ld(unsigned* p) { return __hip_atomic_load(p, __ATOMIC_RELAXED, __HIP_MEMORY_SCOPE_AGENT); }
DI unsigned xb_add(unsigned* p, unsigned v) { return __hip_atomic_fetch_add(p, v, __ATOMIC_RELAXED, __HIP_MEMORY_SCOPE_AGENT); }
DI unsigned xb_xcc_id() { return (unsigned)__builtin_amdgcn_s_getreg((3 << 11) | 20) & 0xFu; }
#define XB_SPIN(cond, bar) do { unsigned _sp = 0; while (cond) { __builtin_amdgcn_s_sleep(1); \
    if ((++_sp & 255u) == 0u) { if (xb_ld(&(bar)[XB_TMO])) break; if (_sp > XB_SPIN_CAP) { atomicAdd(&(bar)[XB_TMO], 1u); break; } } } } while (0)
struct XcdBarrier { unsigned* bar; unsigned x; unsigned rank; volatile LAS unsigned* st; };
DI XcdBarrier xcd_barrier_post(unsigned* bar, volatile LAS unsigned* st) {
  XcdBarrier b; b.bar = bar; b.x = xb_xcc_id(); b.st = st;
  b.rank = 0u;
  if (threadIdx.x == 0) b.rank = xb_add(&bar[XB_XCNT(b.x)], 1u);
  return b;
}
DI void xcd_barrier_complete(unsigned* bar, unsigned x, unsigned& nloc, unsigned& nx) {
  const unsigned G = gridDim.x * gridDim.y * gridDim.z;
  unsigned sum, cnt, mine, sp = 0u;
  for (;;) {
    sum = 0u; cnt = 0u; mine = 0u;
#pragma unroll
    for (unsigned j = 0; j < 16; ++j) { const unsigned c = xb_ld(&bar[XB_XCNT(j)]); sum += c; cnt += (c > 0u) ? 1u : 0u; mine = (j == x) ? c : mine; }
    if (sum == G) break;
    __builtin_amdgcn_s_sleep(1);
    if ((++sp & 255u) == 0u) { if (xb_ld(&bar[XB_TMO])) break; if (sp > XB_SPIN_CAP) { atomicAdd(&bar[XB_TMO], 1u); break; } }
  }
  nloc = mine > 0u ? mine : 1u; nx = cnt > 0u ? cnt : 1u;
}
DI void xcd_barrier(unsigned* bar_, volatile LAS unsigned* st_) {
  XcdBarrier b; b.bar = bar_; b.st = st_; b.x = xb_xcc_id(); b.rank = 0u;
  asm volatile("s_waitcnt vmcnt(0)" ::: "memory");
  __syncthreads();
  if (threadIdx.x == 0) {
    unsigned* bar = b.bar;
    __builtin_amdgcn_s_waitcnt(0);
    unsigned nloc = b.st[0], nx = b.st[1];
    if (nloc == 0u) { xcd_barrier_complete(bar, b.x, nloc, nx); b.st[0] = nloc; b.st[1] = nx; }
    const unsigned old = xb_add(&bar[XB_XSUB(b.x)], 1u);
    const unsigned gen = old / nloc;
    if (old + 1u == (gen + 1u) * nloc) {
      __builtin_amdgcn_fence(__ATOMIC_RELEASE, "agent");
      asm volatile("s_waitcnt vmcnt(0)" ::: "memory");
      const unsigned og = xb_add(&bar[XB_TOP], 1u);
      const unsigned tg = og / nx;
      if (og + 1u == (tg + 1u) * nx) xb_add(&bar[XB_TOPGEN], 1u);
      else XB_SPIN(xb_ld(&bar[XB_TOPGEN]) == tg, bar);
      __builtin_amdgcn_fence(__ATOMIC_ACQUIRE, "agent");
      xb_add(&bar[XB_XGEN(b.x)], 1u);
      asm volatile("s_waitcnt vmcnt(0)" ::: "memory");
    } else {
      XB_SPIN(xb_ld(&bar[XB_XGEN(b.x)]) == gen, bar);
      __builtin_amdgcn_fence(__ATOMIC_ACQUIRE, "agent");
      asm volatile("s_waitcnt vmcnt(0)" ::: "memory");
    }
  }
  __syncthreads();
}

#define GEMM_PHASE(MTn, NTn, BODY)                                                     \
  {                                                                                    \
    const int per_ = G >> 3, ntile_ = (MTn) * (NTn);                                   \
    for (int s_ = 0; s_ * G < ntile_; ++s_) {                                          \
      const int idx_ = s_ * G + vbs[1] * per_ + vbs[2];                                \
      if (idx_ < ntile_) { const int mt = idx_ / (NTn), nt = idx_ % (NTn); BODY }      \
    }                                                                                  \
  }
#define GEMM_PHASE_SK(MTn, NTn, NPB, NC, SKIP, BODY)                                   \
  {                                                                                    \
    const int per_ = G >> 3, mtn_ = (SKIP) ? (MTn) - NB * (NC) : (MTn), ntile_ = mtn_ * (NTn); \
    for (int s_ = 0; s_ * G < ntile_; ++s_) {                                          \
      const int idx_ = s_ * G + vbs[1] * per_ + vbs[2];                                \
      if (idx_ < ntile_) {                                                             \
        const int ml_ = idx_ / (NTn), nt = idx_ % (NTn);                               \
        const int mt = (SKIP) ? (ml_ / ((NPB) - (NC))) * (NPB) + (NC) + ml_ % ((NPB) - (NC)) : ml_; \
        BODY                                                                           \
      }                                                                                \
    }                                                                                  \
  }

__global__ void __launch_bounds__(512, 2) hybrid_fwd(Params p0) {
  extern __shared__ __attribute__((aligned(16))) unsigned char smem[];
  cg::grid_group grid = cg::this_grid();
  const int G = gridDim.x, bid = blockIdx.x;
  volatile LAS unsigned* xst = (volatile LAS unsigned*)(smem + LDS_MAIN + 1024);
  if (threadIdx.x == 0) { xst[0] = 0u; xst[1] = 0u; }
  __syncthreads();
  volatile int* vbs = (volatile int*)(smem + LDS_MAIN + 1280);
  {
    const XcdBarrier xb = xcd_barrier_post((unsigned*)(p0.ws + OFF_BAR), xst);
    if (threadIdx.x == 0) { vbs[1] = bid & 7; vbs[2] = bid >> 3; vbs[3] = (int)xb.x; vbs[4] = (int)xb.rank; }
  }
  for (int ph = p0.ph_lo; ph < p0.ph_hi; ++ph) {
    const Params& p = p0;
    if (ph == 0) {
      const int n0 = 192, n1 = n0 + 256, n2 = n1 + NCONV_EARLY;
      for (int it = bid; it < n2; it += G) {
        if (it < n0) cmod_item(p, it, smem);
        else if (it < n1) rope_item(p, it - n0);
        else convw_item(p, 0, it - n1, smem);
      }
    } else if (ph == 23) {
      for (int it = bid; it < NB * SEQL / 8; it += G) final_item(p, it);
    } else {
      const int l = (ph - 1) / 11, sp = (ph - 1) % 11;
      const bool skipctx = (l == 1);
      const int nrep = ((TW >> sp) & 1) ? 2 : 1;
      for (int rep = 0; rep < nrep; ++rep) {
      if (rep) xcd_barrier((unsigned*)(p0.ws + OFF_BAR), xst);
      switch (sp) {
        case 0: {
          const int n0 = R / 8, n1 = n0;
          for (int it = bid; it < n1; it += G) {
            if (it < n0) normmod_item(p, l, 0, l == 0, (us*)(p.ws + OFF_H), it);
            else convw_item(p, 1, it - n0, smem);
          }
        } break;
        case 1:
          GEMM_PHASE(MT, 13, if (nt < 12) inproj_tile(p, l, mt, nt, smem); else inproj_tile_dt(p, l, mt, smem);)
          {
            unsigned* cq = (unsigned*)(p.ws + OFF_CTL) + 8 + l;
            int* bc = (int*)(smem + LDS_MAIN + 1152);
            while (true) {
              __syncthreads();
              if (threadIdx.x == 0) *bc = (int)atomicAdd(cq, 1u);
              __syncthreads();
              const int it = *bc;
              if (it >= NCONV_ITEMS - NCONV_EARLY) break;
              convw_item(p, l, NCONV_EARLY + it, smem);
            }
          }
          break;
        case 2:
          for (int it = bid; it < NB * 34 * 24; it += G) conv_item(p, l, it, smem);
          break;
        case 3: {
          const int nitems = 128 + 1024 + (l == 0 ? 64 : 0);
          unsigned* ctr = (unsigned*)(p.ws + OFF_CTL) + l + 2 * rep;
          int* bc = (int*)(smem + LDS_MAIN + 1152);
          while (true) {
            __syncthreads();
            if (threadIdx.x == 0) *bc = (int)atomicAdd(ctr, 1u);
            __syncthreads();
            const int it = *bc;
            if (it >= nitems) break;
            mixer_item(p, l, it, smem);
          }
        } break;
        case 4:
          for (int it = bid; it < 128 * 17; it += G) ssd_fix_item(p, l, it);
          break;
        case 5:
          GEMM_PHASE_SK(MT, 4, 17, 1, true, zgate_tile_w(p, l, mt * 256, nt, smem);)
          if (!skipctx) GEMM_PHASE(8, 8, zgate_tile<2>(p, l, (mt >> 1) * POS + (mt & 1) * 128, nt, smem);)
          break;
        case 6:
          GEMM_PHASE_SK(MT, 8, 17, 1, true, merge_tile<4>(p, l, mt * 256, nt, smem);)
          if (!skipctx) GEMM_PHASE(8, 8, merge_tile<2>(p, l, (mt >> 1) * POS + (mt & 1) * 128, nt, smem);)
          break;
        case 7:
          GEMM_PHASE_SK(MT, 4, 17, 1, true, resid_tile_w(p, l, mt * 256, nt, (const us*)(p.ws + OFF_M), 1024, (const us*)p.ws + W_WOUT, 2 * DM, l == 0, smem);)
          if (!skipctx) GEMM_PHASE(8, 8, resid_tile<2>(p, l, (mt >> 1) * POS + (mt & 1) * 128, nt, (const us*)(p.ws + OFF_M), 1024, (const us*)p.ws + W_WOUT, 2 * DM, l == 0, smem);)
          break;
        case 8:
          for (int it = bid; it < R / 8; it += G) {
            if (skipctx && ((it * 8) % POS) < LC) continue;
            normmod_item(p, l, 1, false, (us*)(p.ws + OFF_H2), it);
          }
          break;
        case 9:
          GEMM_PHASE_SK(76, 22, 19, 2, skipctx, ffn1_tile(p, l, mt, nt, smem);)
          break;
        case 10:
          GEMM_PHASE_SK(MT, 4, 17, 1, true, resid_tile_w(p, l, mt * 256, nt, (const us*)(p.ws + OFF_ACT), DFF, (const us*)p.ws + W_WDN, 5 * DM, false, smem);)
          if (!skipctx) GEMM_PHASE(8, 8, resid_tile<2>(p, l, (mt >> 1) * POS + (mt & 1) * 128, nt, (const us*)(p.ws + OFF_ACT), DFF, (const us*)p.ws + W_WDN, 5 * DM, false, smem);)
          if (l == 0) {
            unsigned* cq = (unsigned*)(p.ws + OFF_CTL) + 12;
            int* bc = (int*)(smem + LDS_MAIN + 1152);
            while (true) {
              __syncthreads();
              if (threadIdx.x == 0) *bc = (int)atomicAdd(cq, 1u);
              __syncthreads();
              const int it = *bc;
              if (it >= NCONV_EARLY) break;
              convw_item(p, 1, it, smem);
            }
          }
          break;
      }
      }
    }
    if (ph + 1 < p0.ph_hi) {
      if (ph == 0) {
        grid.sync();
        if (threadIdx.x == 0) {
          unsigned* bar = (unsigned*)(p0.ws + OFF_BAR);
          bool ok = (G & 7) == 0;
          for (unsigned j = 0; j < 16; ++j) { const unsigned c = xb_ld(&bar[XB_XCNT(j)]); if (j < 8 ? c != (unsigned)(G >> 3) : c != 0u) ok = false; }
          if (ok) { vbs[1] = vbs[3]; vbs[2] = vbs[4]; }
        }
        __syncthreads();
      }
      else xcd_barrier((unsigned*)(p0.ws + OFF_BAR), xst);
    }
  }
}

extern "C" void kernel_launch(void* const* d_in, const int* in_sizes, int n_in, void* d_out, int out_size, void* d_ws, size_t ws_size,
                              hipStream_t stream) {
  static int grid_blocks = 0;
  if (grid_blocks == 0) {
    if (ws_size < WS_NEED || n_in != 28) { fprintf(stderr, "kernel_launch: ws %zu < %zu or n_in %d\n", ws_size, (size_t)WS_NEED, n_in); grid_blocks = -1; return; }
    int dev = 0, cus = 0, per_cu = 0;
    (void)hipGetDevice(&dev);
    (void)hipDeviceGetAttribute(&cus, hipDeviceAttributeMultiprocessorCount, dev);
    (void)hipFuncSetAttribute((const void*)hybrid_fwd, hipFuncAttributeMaxDynamicSharedMemorySize, LDS_BYTES);
    (void)hipOccupancyMaxActiveBlocksPerMultiprocessor(&per_cu, (const void*)hybrid_fwd, NTHR, LDS_BYTES);
    if (per_cu < 1) { fprintf(stderr, "kernel_launch: occupancy query %d\n", per_cu); grid_blocks = -1; return; }
    grid_blocks = cus;
  }
  if (grid_blocks < 0) return;
  (void)hipMemsetAsync((unsigned char*)d_ws + OFF_CTL, 0, 256 + 3456 * 4, stream);
  Params p{};
  const float** pp = (const float**)&p;
  for (int i = 0; i < 28; ++i) pp[i] = (const float*)d_in[i];
  p.out = (float*)d_out; p.ws = (unsigned char*)d_ws; p.ph_lo = 0; p.ph_hi = 24;
  void* args[] = {&p};
  hipError_t e = hipLaunchCooperativeKernel((const void*)hybrid_fwd, dim3(grid_blocks), dim3(NTHR), args, LDS_BYTES, stream);
  if (e != hipSuccess) fprintf(stderr, "cooperative launch failed: %s (grid %d)\n", hipGetErrorString(e), grid_blocks);
}
```

```cpp
#include <hip/hip_runtime.h>
#include <hip/hip_cooperative_groups.h>
#include <cstdio>
namespace cg = cooperative_groups;

#define DI __device__ __forceinline__
#define LAS __attribute__((address_space(3)))
typedef unsigned short us;
typedef __attribute__((ext_vector_type(8))) __bf16 b16x8;
typedef __attribute__((ext_vector_type(2))) __bf16 b16x2;
typedef __attribute__((ext_vector_type(16))) float f32x16;
typedef __attribute__((ext_vector_type(4))) float f32x4;
typedef __attribute__((ext_vector_type(4))) unsigned u32x4;
typedef __attribute__((ext_vector_type(2))) unsigned u32x2;

constexpr int NB = 4, SEQL = 4096, DM = 1024, LC = 256, POS = LC + SEQL, R = NB * POS;
constexpr int INW = 7200, DFF = 2816;
constexpr int MT = R / 256;
constexpr float EPS = 1e-6f;
constexpr float LOG2E = 1.4426950408889634f;

constexpr size_t S1 = (size_t)R * 1024 * 2, S05 = S1 / 2, S025 = S1 / 4, S0125 = S1 / 8, S15 = S1 + S05;
constexpr size_t EL_WIN = (size_t)7296 * 1024, EL_WOA = 1024 * 512, EL_WOB = 1024 * 1024, EL_WOC = 1024 * 512, EL_WOUT = 1024 * 1024,
                 EL_WUG = (size_t)5632 * 1024, EL_WDN = (size_t)1024 * 2816;
constexpr size_t W_WIN = 0, W_WOA = W_WIN + EL_WIN, W_WOB = W_WOA + EL_WOA, W_WOC = W_WOB + EL_WOB, W_WOUT = W_WOC + EL_WOC,
                 W_WUG = W_WOUT + EL_WOUT, W_WDN = W_WUG + EL_WUG, W_END = W_WDN + EL_WDN;
constexpr size_t OFF_R1 = W_END * 2;
constexpr size_t OFF_H = OFF_R1, OFF_XBCRAW = OFF_R1 + S1;
constexpr size_t OFF_YF = OFF_R1 + S1, OFF_YB = OFF_R1 + 2 * S1;
constexpr size_t OFF_ACT = OFF_R1;
constexpr size_t OFF_R2 = OFF_R1 + 3 * S1;
constexpr size_t OFF_QA = OFF_R2, OFF_QC = OFF_QA + S05, OFF_KA = OFF_QC + S05, OFF_KC = OFF_KA + S0125, OFF_VAT = OFF_KC + S0125, OFF_VCT = OFF_VAT + S0125;
constexpr size_t OFF_YA = OFF_QA, OFF_YC = OFF_QC;
constexpr size_t OFF_H2 = OFF_R2;
constexpr size_t OFF_R3 = OFF_R2 + S15;
constexpr size_t OFF_XT = OFF_R3, OFF_BN = OFF_XT + S1, OFF_BT = OFF_BN + S025, OFF_CN = OFF_BT + S025;
constexpr size_t OFF_M = OFF_R3, OFF_XC = OFF_R3 + S1;
constexpr size_t OFF_DT = OFF_R3 + S1 + 3 * S025;
constexpr size_t OFF_CMOD = OFF_DT + (size_t)R * 32 * 4;
constexpr size_t OFF_PART = OFF_CMOD + 2 * 5 * 6144 * 4;
constexpr size_t OFF_ROPE = OFF_PART + (size_t)R * 8 * 4;
constexpr size_t OFF_CTL = OFF_ROPE + 4096 * 32 * 8;
constexpr size_t OFF_BAR = OFF_CTL + 256;
constexpr size_t OFF_HMID = OFF_BAR + 14080;
constexpr size_t OFF_CUMP = OFF_HMID + (size_t)128 * 8192 * 2;
constexpr size_t WS_NEED = OFF_CUMP + 128 * 34 * 4;
struct Params {
  const float *x, *c, *ctx, *c_ctx, *w_mod, *b_mod, *norm1, *norm2, *w_in, *a_sink, *ssm_conv_w, *ssm_conv_b, *ssm_A_log, *ssm_dt_bias,
      *ssm_D, *ssm_norm, *c_q_norm, *c_k_norm, *w_oa, *w_ob, *w_oc, *w_out, *ffn_w_up, *ffn_w_gate, *ffn_conv_w, *ffn_conv_b, *ffn_w_down, *final_norm;
  float* out;
  unsigned char* ws;
  int ph_lo, ph_hi;
};

DI unsigned pk2(float a, float b) { b16x2 v; v[0] = (__bf16)a; v[1] = (__bf16)b; return __builtin_bit_cast(unsigned, v); }
DI us f2bf(float a) { __bf16 v = (__bf16)a; return __builtin_bit_cast(us, v); }
DI float bflo(unsigned u) { return __uint_as_float(u << 16); }
DI float bfhi(unsigned u) { return __uint_as_float(u & 0xffff0000u); }
DI float bf2f(us u) { return __uint_as_float(((unsigned)u) << 16); }
DI int tidx() { int t = threadIdx.x; asm volatile("" : "+v"(t) :: "memory"); return t; }
DI int crow(int reg, int h) { return (reg & 3) + 8 * (reg >> 2) + 4 * h; }
DI float silu(float v) { return v * __builtin_amdgcn_rcpf(1.f + __expf(-v)); }
DI float sigmoidf(float v) { return __builtin_amdgcn_rcpf(1.f + __expf(-v)); }
DI f32x16 mfma(b16x8 a, b16x8 b, f32x16 c) { return __builtin_amdgcn_mfma_f32_32x32x16_bf16(a, b, c, 0, 0, 0); }
DI b16x8 ldsfrag(const unsigned char* p) { return __builtin_bit_cast(b16x8, *(const u32x4*)p); }
DI b16x8 ldsfrag2(const unsigned char* p0, const unsigned char* p1) {
  u32x2 a = *(const u32x2*)p0, b = *(const u32x2*)p1; u32x4 v; v[0] = a[0]; v[1] = a[1]; v[2] = b[0]; v[3] = b[1];
  return __builtin_bit_cast(b16x8, v);
}
DI f32x16 fzero() { f32x16 z; for (int i = 0; i < 16; ++i) z[i] = 0.f; return z; }

DI const float* xrow_r(const Params& p, bool use_in, int row) {
  int b = row / POS, pos = row - b * POS;
  if (pos < LC) return (use_in ? p.ctx : (const float*)(p.ws + OFF_XC)) + ((size_t)(b * LC + pos)) * DM;
  return (use_in ? p.x : (const float*)p.out) + ((size_t)(b * SEQL + pos - LC)) * DM;
}
DI float* xrow_w(const Params& p, int row) {
  int b = row / POS, pos = row - b * POS;
  if (pos < LC) return (float*)(p.ws + OFF_XC) + ((size_t)(b * LC + pos)) * DM;
  return p.out + ((size_t)(b * SEQL + pos - LC)) * DM;
}
DI const float* cmod_row(const Params& p, int l, int row) {
  int b = row / POS, pos = row - b * POS;
  int s = pos < LC ? 4 : b;
  return (const float*)(p.ws + OFF_CMOD) + ((size_t)(l * 5 + s)) * 6144;
}

#define TW 0
constexpr int NTHR = 512;
constexpr int STG = 73728;
constexpr int LDS_MAIN = 2 * STG, LDS_BYTES = LDS_MAIN + 2048;

template <int NBW, int MB = 4>
DI void gemm_tile(f32x16 (&acc)[MB][NBW], const us* A, long lda, int r_lo, int r_hi, const us* Bt, long ldb, int K, unsigned char* smem) {
  const int t = tidx(), lane = t & 63, w = t >> 6, r = lane & 31, h = lane >> 5, wm = w >> 2, wn = w & 3;
  u32x4 pa[MB], pb[2 * NBW];
  const int lrow = t >> 3, lch = t & 7;
  const us* Ap = A + (long)lrow * lda + lch * 8;
  const us* Bp = Bt + (long)lrow * ldb + lch * 8;
  bool av[MB];
#pragma unroll
  for (int i = 0; i < MB; ++i) av[i] = (lrow + 64 * i) >= r_lo && (lrow + 64 * i) < r_hi;
  auto gload = [&](int k0) {
#pragma unroll
    for (int i = 0; i < MB; ++i) {
      if (av[i]) pa[i] = *(const u32x4*)(Ap + (long)(64 * i) * lda + k0);
      else { pa[i][0] = 0; pa[i][1] = 0; pa[i][2] = 0; pa[i][3] = 0; }
    }
#pragma unroll
    for (int i = 0; i < 2 * NBW; ++i) pb[i] = *(const u32x4*)(Bp + (long)(64 * i) * ldb + k0);
  };
  auto lstore = [&](int st) {
    unsigned char* As = smem + st * STG + lrow * 144 + lch * 16; unsigned char* Bs = As + 36864;
#pragma unroll
    for (int i = 0; i < MB; ++i) *(u32x4*)(As + i * 64 * 144) = pa[i];
#pragma unroll
    for (int i = 0; i < 2 * NBW; ++i) *(u32x4*)(Bs + i * 64 * 144) = pb[i];
  };
  auto compute = [&](int st, int ks0, int ks1) {
    const unsigned char* As = smem + st * STG + (wm * 32 * MB + r) * 144 + 16 * h;
    const unsigned char* Bs = smem + st * STG + 36864 + (wn * 32 * NBW + r) * 144 + 16 * h;
#pragma unroll
    for (int ks = ks0; ks < ks1; ++ks) {
      b16x8 fa[MB], fb[NBW];
#pragma unroll
      for (int mb = 0; mb < MB; ++mb) fa[mb] = ldsfrag(As + mb * 32 * 144 + ks * 32);
#pragma unroll
      for (int nb = 0; nb < NBW; ++nb) fb[nb] = ldsfrag(Bs + nb * 32 * 144 + ks * 32);
#pragma unroll
      for (int nb = 0; nb < NBW; ++nb)
#pragma unroll
        for (int mb = 0; mb < MB; ++mb) acc[mb][nb] = mfma(fa[mb], fb[nb], acc[mb][nb]);
    }
  };
#pragma unroll
  for (int i = 0; i < MB; ++i)
#pragma unroll
    for (int j = 0; j < NBW; ++j) acc[i][j] = fzero();
  const int nk = K / 64;
  gload(0); lstore(0);
  __syncthreads();
  for (int kt = 0; kt < nk; ++kt) {
    if (kt + 1 < nk) gload((kt + 1) * 64);
    if (NBW == 2 && MB == 4) {
      __builtin_amdgcn_sched_barrier(0);
      compute(kt & 1, 0, 3);
      __builtin_amdgcn_sched_barrier(0);
      compute(kt & 1, 3, 4);
      if (kt + 1 < nk) lstore((kt + 1) & 1);
      __builtin_amdgcn_sched_group_barrier(0x100, 6, 0);
#pragma unroll
      for (int i = 0; i < 8; ++i) { __builtin_amdgcn_sched_group_barrier(0x008, 1, 0); __builtin_amdgcn_sched_group_barrier(0x200, 1, 0); }
      __builtin_amdgcn_sched_barrier(0);
    } else {
      compute(kt & 1, 0, 4);
      if (kt + 1 < nk) lstore((kt + 1) & 1);
    }
    __syncthreads();
  }
}
DI f32x4 mfma16(b16x8 a, b16x8 b, f32x4 c) { return __builtin_amdgcn_mfma_f32_16x16x32_bf16(a, b, c, 0, 0, 0); }
template <int NBW>
DI void gemm_tile16(f32x4 (&acc)[8][2 * NBW], const us* A, long lda, int r_lo, int r_hi, const us* Bt, long ldb, int K, unsigned char* smem) {
  const int t = tidx(), lane = t & 63, w = t >> 6, r = lane & 15, quad = lane >> 4, wm = w >> 2, wn = w & 3;
  const int srow = lane >> 3, spos = lane & 7;
  auto stage = [&](int st, int k0) {
#pragma unroll
    for (int i = 0; i < 4; ++i) {
      const int row = w * 32 + i * 8 + srow;
      int rs_ = row < r_lo ? r_lo : row; rs_ = rs_ >= r_hi ? r_hi - 1 : rs_;
      const us* src = A + (long)rs_ * lda + k0 + ((spos ^ ((row >> 1) & 7)) << 3);
      __builtin_amdgcn_global_load_lds((const unsigned*)src, (LAS unsigned*)(smem + st * STG + (w * 32 + i * 8) * 128), 16, 0, 0);
    }
#pragma unroll
    for (int i = 0; i < 2 * NBW; ++i) {
      const int row = w * 16 * NBW + i * 8 + srow;
      const us* src = Bt + (long)row * ldb + k0 + ((spos ^ ((row >> 1) & 7)) << 3);
      __builtin_amdgcn_global_load_lds((const unsigned*)src, (LAS unsigned*)(smem + st * STG + 32768 + (w * 16 * NBW + i * 8) * 128), 16, 0, 0);
    }
  };
  auto compute = [&](int st, int ks0, int ks1) {
    const unsigned char* Ab = smem + st * STG + (wm * 128 + r) * 128;
    const unsigned char* Bb = smem + st * STG + 32768 + (wn * 32 * NBW + r) * 128;
    const int g = (r >> 1) & 7;
#pragma unroll
    for (int ks = ks0; ks < ks1; ++ks) {
      const int off = ((((ks * 4) ^ (g & 4)) + (quad ^ (g & 3))) << 4);
      b16x8 fb[2 * NBW];
#pragma unroll
      for (int nt = 0; nt < 2 * NBW; ++nt) fb[nt] = ldsfrag(Bb + nt * 16 * 128 + off);
#pragma unroll
      for (int hf = 0; hf < 2; ++hf) {
        b16x8 fa[4];
#pragma unroll
        for (int m = 0; m < 4; ++m) fa[m] = ldsfrag(Ab + (hf * 4 + m) * 16 * 128 + off);
#pragma unroll
        for (int m = 0; m < 4; ++m)
#pragma unroll
          for (int nt = 0; nt < 2 * NBW; ++nt) acc[hf * 4 + m][nt] = mfma16(fa[m], fb[nt], acc[hf * 4 + m][nt]);
      }
    }
  };
#pragma unroll
  for (int i = 0; i < 8; ++i)
#pragma unroll
    for (int j = 0; j < 2 * NBW; ++j) { acc[i][j][0] = 0.f; acc[i][j][1] = 0.f; acc[i][j][2] = 0.f; acc[i][j][3] = 0.f; }
  const int nk = K / 64;
  stage(0, 0);
  asm volatile("s_waitcnt vmcnt(0)" ::: "memory");
  __syncthreads();
  for (int kt = 0; kt < nk; ++kt) {
    if (kt + 1 < nk) stage((kt + 1) & 1, (kt + 1) * 64);
#pragma unroll
    for (int ks = 0; ks < 2; ++ks) {
      __builtin_amdgcn_sched_barrier(0);
      compute(kt & 1, ks, ks + 1);
      if (NBW == 2) {
        __builtin_amdgcn_sched_group_barrier(0x100, 12, 0); __builtin_amdgcn_sched_group_barrier(0x008, 32, 0);
      } else {
        __builtin_amdgcn_sched_group_barrier(0x100, 6, 0); __builtin_amdgcn_sched_group_barrier(0x008, 6, 0);
        __builtin_amdgcn_sched_group_barrier(0x100, 4, 0); __builtin_amdgcn_sched_group_barrier(0x008, 10, 0);
      }
    }
    __builtin_amdgcn_sched_barrier(0);
    asm volatile("s_waitcnt vmcnt(0)" ::: "memory");
    __syncthreads();
  }
}
template <int NBW>
DI void acc_to_lds16(const f32x4 (&acc)[8][2 * NBW], int half, unsigned char* smem) {
  const int t = tidx(), lane = t & 63, w = t >> 6, r = lane & 15, quad = lane >> 4, wm = w >> 2, wn = w & 3;
  float* Cs = (float*)smem;
  if (NBW == 2 && (wn >> 1) != half) return;
  const int cbase = (NBW == 2) ? (wn & 1) * 64 : wn * 32;
#pragma unroll
  for (int mt = 0; mt < 8; ++mt)
#pragma unroll
    for (int nt = 0; nt < 2 * NBW; ++nt)
#pragma unroll
      for (int i = 0; i < 4; ++i) Cs[(wm * 128 + mt * 16 + quad * 4 + i) * 132 + cbase + nt * 16 + r] = acc[mt][nt][i];
}
template <int NBW, int MB = 4>
DI void acc_to_lds(const f32x16 (&acc)[MB][NBW], int half, unsigned char* smem) {
  const int t = tidx(), lane = t & 63, w = t >> 6, r = lane & 31, h = lane >> 5, wm = w >> 2, wn = w & 3;
  float* Cs = (float*)smem;
  if (NBW == 2 && (wn >> 1) != half) return;
  const int cbase = (NBW == 2) ? (wn & 1) * 64 : wn * 32;
#pragma unroll
  for (int mb = 0; mb < MB; ++mb)
#pragma unroll
    for (int nb = 0; nb < NBW; ++nb)
#pragma unroll
      for (int i = 0; i < 16; ++i) Cs[(wm * 32 * MB + mb * 32 + crow(i, h)) * 132 + cbase + nb * 32 + r] = acc[mb][nb][i];
}
DI void lds_row8(const unsigned char* smem, int row, int cg8, float (&v)[8]) {
  const float* Cs = (const float*)smem + row * 132 + cg8 * 8;
  f32x4 a = *(const f32x4*)Cs, b = *(const f32x4*)(Cs + 4);
  v[0] = a[0]; v[1] = a[1]; v[2] = a[2]; v[3] = a[3]; v[4] = b[0]; v[5] = b[1]; v[6] = b[2]; v[7] = b[3];
}
DI void store8bf(us* dst, const float (&v)[8]) {
  u32x4 o; o[0] = pk2(v[0], v[1]); o[1] = pk2(v[2], v[3]); o[2] = pk2(v[4], v[5]); o[3] = pk2(v[6], v[7]);
  *(u32x4*)dst = o;
}
DI void load8bf(const us* src, float (&v)[8]) {
  u32x4 o = *(const u32x4*)src;
  v[0] = bflo(o[0]); v[1] = bfhi(o[0]); v[2] = bflo(o[1]); v[3] = bfhi(o[1]); v[4] = bflo(o[2]); v[5] = bfhi(o[2]); v[6] = bflo(o[3]); v[7] = bfhi(o[3]);
}

DI void cmod_item(const Params& p, int it, unsigned char* smem) {
  const int t = tidx();
  float* sv = (float*)smem;
  float* red = sv + 5 * 1024;
  for (int i = t; i < 5 * 1024; i += NTHR) {
    int s = i >> 10, k = i & 1023;
    float v = s < 4 ? p.c[s * 1024 + k] : p.c_ctx[k];
    sv[i] = v / (1.f + expf(-v));
  }
  __syncthreads();
  const int l = it / 96, n0 = (it % 96) * 64, col = t & 63, kg = t >> 6;
  const float* W = p.w_mod + (size_t)l * 1024 * 6144 + n0 + col;
  float a0 = 0, a1 = 0, a2 = 0, a3 = 0, a4 = 0;
  for (int k = kg * 128; k < kg * 128 + 128; ++k) {
    float wv = W[(size_t)k * 6144];
    a0 += sv[k] * wv; a1 += sv[1024 + k] * wv; a2 += sv[2048 + k] * wv; a3 += sv[3072 + k] * wv; a4 += sv[4096 + k] * wv;
  }
  red[(kg * 5 + 0) * 64 + col] = a0; red[(kg * 5 + 1) * 64 + col] = a1; red[(kg * 5 + 2) * 64 + col] = a2;
  red[(kg * 5 + 3) * 64 + col] = a3; red[(kg * 5 + 4) * 64 + col] = a4;
  __syncthreads();
  if (t < 320) {
    int s = t >> 6, cc = t & 63;
    float v = 0.f;
#pragma unroll
    for (int g = 0; g < 8; ++g) v += red[(g * 5 + s) * 64 + cc];
    v += p.b_mod[l * 6144 + n0 + cc];
    ((float*)(p.ws + OFF_CMOD))[((size_t)(l * 5 + s)) * 6144 + n0 + cc] = v;
  }
  __syncthreads();
}
DI void rope_item(const Params& p, int it) {
  int idx = it * NTHR + tidx();
  int tok = idx >> 5, i = idx & 31;
  float inv = exp2f(-(float)(i & 15) * (13.287712379549449f / 16.f));
  float pos = (i < 16) ? (float)(tok >> 6) : (float)(tok & 63);
  float ang = pos * inv;
  float* T = (float*)(p.ws + OFF_ROPE);
  T[idx * 2] = cosf(ang); T[idx * 2 + 1] = sinf(ang);
}
constexpr int NCONV_ITEMS = 2352;
constexpr int NCONV_EARLY = 400;
DI void convw_item(const Params& p, int l, int it, unsigned char* smem) {
  const float* src; int ld, col0, nvalid, K, blk, off; size_t dsto; int nblk;
  us* Wb = (us*)p.ws;
  const float* win = p.w_in + (size_t)l * 1024 * INW;
  int j = 0, base = 0;
#define CJ(n) if (j == base && it >= acc_ + (n)) { acc_ += (n); ++j; } ++base;
  int acc_ = 0;
  CJ(96) CJ(96) CJ(192) CJ(16) CJ(128) CJ(384) CJ(64) CJ(128) CJ(64) CJ(128) CJ(352) CJ(352)
#undef CJ
  int loc = it - acc_;
  switch (j) {
    case 0: src = win; ld = INW; col0 = 0; nvalid = 768; nblk = 12; K = 1024; dsto = W_WIN; blk = 64; off = 0; break;
    case 1: src = win; ld = INW; col0 = 3360; nvalid = 768; nblk = 12; K = 1024; dsto = W_WIN + (size_t)768 * 1024; blk = 64; off = 0; break;
    case 2: src = win; ld = INW; col0 = 1792; nvalid = 1536; nblk = 24; K = 1024; dsto = W_WIN + (size_t)1536 * 1024; blk = 64; off = 0; break;
    case 3: src = win; ld = INW; col0 = 3328; nvalid = 32; nblk = 2; K = 1024; dsto = W_WIN + (size_t)3072 * 1024; blk = 64; off = 0; break;
    case 4: src = win; ld = INW; col0 = 768; nvalid = 1024; nblk = 16; K = 1024; dsto = W_WIN + (size_t)3200 * 1024; blk = 64; off = 0; break;
    case 5: src = win; ld = INW; col0 = 4128; nvalid = 3072; nblk = 48; K = 1024; dsto = W_WIN + (size_t)4224 * 1024; blk = 64; off = 0; break;
    case 6: src = p.w_oa + (size_t)l * 512 * 1024; ld = 1024; col0 = 0; nvalid = 1024; nblk = 16; K = 512; dsto = W_WOA; blk = 64; off = 0; break;
    case 7: src = p.w_ob + (size_t)l * 1024 * 1024; ld = 1024; col0 = 0; nvalid = 1024; nblk = 16; K = 1024; dsto = W_WOB; blk = 64; off = 0; break;
    case 8: src = p.w_oc + (size_t)l * 512 * 1024; ld = 1024; col0 = 0; nvalid = 1024; nblk = 16; K = 512; dsto = W_WOC; blk = 64; off = 0; break;
    case 9: src = p.w_out + (size_t)l * 1024 * 1024; ld = 1024; col0 = 0; nvalid = 1024; nblk = 16; K = 1024; dsto = W_WOUT; blk = 64; off = 0; break;
    case 10: src = p.ffn_w_gate + (size_t)l * 1024 * DFF; ld = DFF; col0 = 0; nvalid = DFF; nblk = 44; K = 1024; dsto = W_WUG; blk = 128; off = 0; break;
    case 11: src = p.ffn_w_up + (size_t)l * 1024 * DFF; ld = DFF; col0 = 0; nvalid = DFF; nblk = 44; K = 1024; dsto = W_WUG; blk = 128; off = 64; break;
    default: src = p.ffn_w_down + (size_t)l * DFF * 1024; ld = 1024; col0 = 0; nvalid = 1024; nblk = 16; K = DFF; dsto = W_WDN; blk = 64; off = 0; break;
  }
  const int nb2 = nblk >> 1;
  const int nb0 = (loc % nb2) * 2, kb = loc / nb2;
  float* tile = (float*)smem;
  const int t = tidx(), col = t & 127, kq = t >> 7;
  const bool cv = (nb0 * 64 + col) < nvalid;
  float lv[16];
#pragma unroll
  for (int i = 0; i < 16; ++i) lv[i] = cv ? __builtin_nontemporal_load(src + (size_t)(kb * 64 + kq + 4 * i) * ld + col0 + nb0 * 64 + col) : 0.f;
#pragma unroll
  for (int i = 0; i < 16; ++i) tile[(kq + 4 * i) * 129 + col] = lv[i];
  __syncthreads();
  {
    int n = t >> 2, kc = (t & 3) * 16;
    float v[8], u[8];
#pragma unroll
    for (int q = 0; q < 8; ++q) { v[q] = tile[(kc + q) * 129 + n]; u[q] = tile[(kc + 8 + q) * 129 + n]; }
    us* dst = Wb + dsto + (size_t)((nb0 + (n >> 6)) * blk + off + (n & 63)) * K + kb * 64 + kc;
    store8bf(dst, v); store8bf(dst + 8, u);
  }
  __syncthreads();
}

DI void normmod_item(const Params& p, int l, int which, bool use_in, us* dst, int it) {
  const int lane = tidx() & 63, w = tidx() >> 6;
  const int row = it * 8 + w;
  const float* xr = xrow_r(p, use_in, row);
  const float* cm = cmod_row(p, l, row) + (which ? 3 * DM : 0);
  const float* g = (which ? p.norm2 : p.norm1) + l * DM;
  f32x4 v[4]; float ss = 0.f;
#pragma unroll
  for (int i = 0; i < 4; ++i) { v[i] = *(const f32x4*)(xr + i * 256 + lane * 4); ss += v[i][0] * v[i][0] + v[i][1] * v[i][1] + v[i][2] * v[i][2] + v[i][3] * v[i][3]; }
#pragma unroll
  for (int o = 32; o > 0; o >>= 1) ss += __shfl_xor(ss, o);
  const float rstd = rsqrtf(ss * (1.f / DM) + EPS);
#pragma unroll
  for (int i = 0; i < 4; ++i) {
    int c0 = i * 256 + lane * 4;
    f32x4 gg = *(const f32x4*)(g + c0), sh = *(const f32x4*)(cm + c0), sc = *(const f32x4*)(cm + DM + c0);
    float o0 = v[i][0] * rstd * gg[0] * (1.f + sc[0]) + sh[0], o1 = v[i][1] * rstd * gg[1] * (1.f + sc[1]) + sh[1];
    float o2 = v[i][2] * rstd * gg[2] * (1.f + sc[2]) + sh[2], o3 = v[i][3] * rstd * gg[3] * (1.f + sc[3]) + sh[3];
    u32x2 o; o[0] = pk2(o0, o1); o[1] = pk2(o2, o3);
    *(u32x2*)(dst + (size_t)row * DM + c0) = o;
  }
}

DI void inproj_epi(const Params& p, int l, int row0, int nt, unsigned char* smem) {
  const int t = tidx();
  const int b = row0 / POS, pos0 = row0 - b * POS;
  const bool latent = pos0 >= LC;
  if (nt == 5 || nt == 11) {
    us* VT = (us*)(p.ws + (nt == 5 ? OFF_VAT : OFF_VCT));
    const float* Cs = (const float*)smem;
    const int col = t & 127, rg = t >> 7;
#pragma unroll
    for (int itr = 0; itr < 8; ++itr) {
      int rr = rg * 64 + itr * 8; float v[8];
#pragma unroll
      for (int q = 0; q < 8; ++q) v[q] = Cs[(rr + q) * 132 + col];
      store8bf(VT + ((size_t)(b * 128 + col)) * POS + pos0 + rr, v);
    }
  } else if (nt == 24) {
    const float* Cs = (const float*)smem;
    float* DT = (float*)(p.ws + OFF_DT);
    for (int i = t; i < 256 * 32; i += NTHR) {
      int rr = i >> 5, cc = i & 31;
      float v = Cs[rr * 132 + cc] + p.ssm_dt_bias[l * 32 + cc];
      float e = __expf(v);
      float sp = v > 20.f ? v : (e < 0.01f ? e * (1.f - e * (0.5f - e * (1.f / 3.f))) : __logf(1.f + e));
      DT[(size_t)(row0 + rr) * 32 + cc] = sp;
    }
  } else if (nt >= 12) {
    us* X = (us*)(p.ws + OFF_XBCRAW);
    const int cg8 = t & 15;
#pragma unroll
    for (int itr = 0; itr < 8; ++itr) {
      int rr = (t >> 4) + 32 * itr; float v[8];
      lds_row8(smem, rr, cg8, v);
      store8bf(X + (size_t)(row0 + rr) * 1536 + (nt - 12) * 128 + cg8 * 8, v);
    }
  } else {
    const bool isC = nt >= 6;
    const bool isQ = isC ? (nt <= 9) : (nt <= 3);
    us* dst; int ldd, coff;
    if (!isC) { if (isQ) { dst = (us*)(p.ws + OFF_QA); ldd = 512; coff = nt * 128; } else { dst = (us*)(p.ws + OFF_KA); ldd = 128; coff = 0; } }
    else { if (isQ) { dst = (us*)(p.ws + OFF_QC); ldd = 512; coff = (nt - 6) * 128; } else { dst = (us*)(p.ws + OFF_KC); ldd = 128; coff = 0; } }
    const float* gn = isC ? ((isQ ? p.c_q_norm : p.c_k_norm) + l * 64) : nullptr;
    const float qs = isQ ? 0.125f * LOG2E : 1.f;
    const float* ROPE = (const float*)(p.ws + OFF_ROPE);
    const int cg8 = t & 15, d0 = (cg8 & 7) * 8;
    float gnv[8];
#pragma unroll
    for (int q = 0; q < 8; ++q) gnv[q] = isC ? gn[d0 + q] : 1.f;
#pragma unroll
    for (int ib4 = 0; ib4 < 8; ib4 += 4) {
    f32x4 rc[4][2];
    if (latent) {
#pragma unroll
      for (int i4 = 0; i4 < 4; ++i4) {
        const float* cs = ROPE + ((size_t)(pos0 - LC + (t >> 4) + 32 * (ib4 + i4)) * 32 + (d0 >> 1)) * 2;
        rc[i4][0] = *(const f32x4*)cs; rc[i4][1] = *(const f32x4*)(cs + 4);
      }
    }
#pragma unroll
    for (int i4 = 0; i4 < 4; ++i4) {
      const int itr = ib4 + i4;
      int rr = (t >> 4) + 32 * itr; float v[8];
      lds_row8(smem, rr, cg8, v);
      if (isC) {
        float ss = 0.f;
#pragma unroll
        for (int q = 0; q < 8; ++q) ss += v[q] * v[q];
        ss += __shfl_xor(ss, 1); ss += __shfl_xor(ss, 2); ss += __shfl_xor(ss, 4);
        float rstd = rsqrtf(ss * (1.f / 64.f) + EPS);
#pragma unroll
        for (int q = 0; q < 8; ++q) v[q] = v[q] * rstd * gnv[q];
      }
      if (latent) {
        const f32x4 c01 = rc[i4][0], c23 = rc[i4][1];
        float x1, x2;
        x1 = v[0]; x2 = v[1]; v[0] = x1 * c01[0] - x2 * c01[1]; v[1] = x1 * c01[1] + x2 * c01[0];
        x1 = v[2]; x2 = v[3]; v[2] = x1 * c01[2] - x2 * c01[3]; v[3] = x1 * c01[3] + x2 * c01[2];
        x1 = v[4]; x2 = v[5]; v[4] = x1 * c23[0] - x2 * c23[1]; v[5] = x1 * c23[1] + x2 * c23[0];
        x1 = v[6]; x2 = v[7]; v[6] = x1 * c23[2] - x2 * c23[3]; v[7] = x1 * c23[3] + x2 * c23[2];
      }
#pragma unroll
      for (int q = 0; q < 8; ++q) v[q] *= qs;
      store8bf(dst + (size_t)(row0 + rr) * ldd + coff + cg8 * 8, v);
    }
    }
  }
}
DI void inproj_tile(const Params& p, int l, int mt, int nt2, unsigned char* smem) {
  f32x4 acc[8][4];
  const us* H = (const us*)(p.ws + OFF_H);
  const us* Wt = (const us*)p.ws + W_WIN + (size_t)nt2 * 256 * 1024;
  gemm_tile16<2>(acc, H + (size_t)mt * 256 * 1024, 1024, 0, 256, Wt, 1024, 1024, smem);
#pragma unroll
  for (int half = 0; half < 2; ++half) {
    const int nt = nt2 * 2 + half;
    if (nt < 25) {
      acc_to_lds16<2>(acc, half, smem);
      __syncthreads();
      inproj_epi(p, l, mt * 256, nt, smem);
      __syncthreads();
    }
  }
}

DI void inproj_tile_dt(const Params& p, int l, int mt, unsigned char* smem) {
  f32x4 acc[8][2];
  const us* H = (const us*)(p.ws + OFF_H);
  const us* Wt = (const us*)p.ws + W_WIN + (size_t)24 * 128 * 1024;
  gemm_tile16<1>(acc, H + (size_t)mt * 256 * 1024, 1024, 0, 256, Wt, 1024, 1024, smem);
  acc_to_lds16<1>(acc, 0, smem);
  __syncthreads();
  inproj_epi(p, l, mt * 256, 24, smem);
  __syncthreads();
}

DI void conv_item(const Params& p, int l, int it, unsigned char* smem) {
  const int cb = it % 24, rest = it / 24, pb = rest % 34, b = rest / 34;
  const int t = tidx(), ch = t & 63, pg = t >> 6;
  const int c = cb * 64 + ch, p0 = pb * 128 + pg * 16;
  const int seg_lo = (pb < 2) ? 0 : LC, seg_hi = (pb < 2) ? LC : POS;
  us* tl = (us*)smem;
  {
    const us* X = (const us*)(p.ws + OFF_XBCRAW) + (size_t)b * POS * 1536 + cb * 64;
    for (int cidx = t; cidx < 130 * 8; cidx += NTHR) {
      const int rw = cidx >> 3, c8 = cidx & 7, ps = pb * 128 - 1 + rw;
      u32x4 v; v[0] = 0; v[1] = 0; v[2] = 0; v[3] = 0;
      if (ps >= seg_lo && ps < seg_hi) v = *(const u32x4*)(X + (size_t)ps * 1536 + c8 * 8);
      *(u32x4*)(tl + rw * 72 + c8 * 8) = v;
    }
  }
  __syncthreads();
  const float w0 = p.ssm_conv_w[(l * 3 + 0) * 1536 + c], w1 = p.ssm_conv_w[(l * 3 + 1) * 1536 + c], w2 = p.ssm_conv_w[(l * 3 + 2) * 1536 + c];
  const float bias = p.ssm_conv_b[l * 1536 + c];
  float raw[18];
#pragma unroll
  for (int i = 0; i < 18; ++i) raw[i] = bf2f(tl[(pg * 16 + i) * 72 + ch]);
  float o[16];
#pragma unroll
  for (int i = 0; i < 16; ++i) o[i] = silu(bias + w0 * raw[i] + w1 * raw[i + 1] + w2 * raw[i + 2]);
  if (c < 1024) {
    us* XT = (us*)(p.ws + OFF_XT) + ((size_t)(b * 1024 + c)) * POS + p0;
    float v[8], u[8];
#pragma unroll
    for (int q = 0; q < 8; ++q) { v[q] = o[q]; u[q] = o[8 + q]; }
    store8bf(XT, v); store8bf(XT + 8, u);
  } else if (c < 1280) {
    us* BN = (us*)(p.ws + OFF_BN) + ((size_t)(b * POS + p0)) * 256 + (c - 1024);
#pragma unroll
    for (int i = 0; i < 16; ++i) BN[(size_t)i * 256] = f2bf(o[i]);
    us* BT = (us*)(p.ws + OFF_BT) + ((size_t)(b * 256 + c - 1024)) * POS + p0;
    float v[8], u[8];
#pragma unroll
    for (int q = 0; q < 8; ++q) { v[q] = o[q]; u[q] = o[8 + q]; }
    store8bf(BT, v); store8bf(BT + 8, u);
  } else {
    us* CN = (us*)(p.ws + OFF_CN) + ((size_t)(b * POS + p0)) * 256 + (c - 1280);
#pragma unroll
    for (int i = 0; i < 16; ++i) CN[(size_t)i * 256] = f2bf(o[i]);
  }
  __syncthreads();
}

DI void attn_item(const us* Q, const us* Kp, const us* VT, us* O, int b, int head, int q0, int mode, int ntl_dense, bool has_sink, float sink, unsigned char* smem) {
  const int t = tidx(), lane = t & 63, w = t >> 6, r = lane & 31, h = lane >> 5;
  const int kvh = head >> 2;
  const int qpos = q0 + w * 32 + r;
  const int qwlo = q0 + w * 32 - 128, qwhi = q0 + w * 32 + 31 + 128;
  const size_t qrow = (size_t)b * POS + qpos;
  b16x8 qf[4];
#pragma unroll
  for (int s = 0; s < 4; ++s) qf[s] = __builtin_bit_cast(b16x8, *(const u32x4*)(Q + qrow * 512 + head * 64 + 16 * s + 8 * h));
  int lo = 0, ntl = ntl_dense;
  if (mode == 1) { lo = (q0 - 128) / 64; if (lo < 4) lo = 4; int hi = (q0 + 255 + 128) / 64; if (hi > 67) hi = 67; ntl = 4 + (hi - lo + 1); }
  f32x16 o0 = fzero(), o1 = fzero();
  float m = -1e30f, lsum = 0.f;
  const us* Kb = Kp + (size_t)b * POS * 128 + kvh * 64;
  const us* Vb = VT + ((size_t)(b * 128 + kvh * 64)) * POS;
  u32x4 pk_, pv_, qk_, qv_;
  const int lrw = t >> 3, lch = t & 7;
  auto tid = [&](int i) { return (mode == 1 && i >= 4) ? lo + (i - 4) : i; };
  auto gl = [&](u32x4& rk, u32x4& rv, int i) {
    const int tile = tid(i);
    rk = *(const u32x4*)(Kb + (size_t)(tile * 64 + lrw) * 128 + lch * 8);
    rv = *(const u32x4*)(Vb + (size_t)lrw * POS + tile * 64 + lch * 8);
  };
  auto ls = [&](const u32x4& rk, const u32x4& rv, int st) {
    unsigned char* Kd = smem + st * 18432 + lrw * 144 + lch * 16;
    *(u32x4*)Kd = rk; *(u32x4*)(Kd + 9216) = rv;
  };
  auto compute = [&](int st, int it) {
    const int kbase = tid(it) * 64;
    if (mode == 1 && it >= 4 && (kbase > qwhi || kbase + 63 < qwlo)) return;
    const unsigned char* Ks = smem + st * 18432; const unsigned char* Vs = Ks + 9216;
    f32x16 s0 = fzero(), s1 = fzero();
#pragma unroll
    for (int s = 0; s < 4; ++s) {
      b16x8 k0 = ldsfrag(Ks + r * 144 + (16 * s + 8 * h) * 2);
      b16x8 k1 = ldsfrag(Ks + (32 + r) * 144 + (16 * s + 8 * h) * 2);
      s0 = mfma(k0, qf[s], s0); s1 = mfma(k1, qf[s], s1);
    }
    if (mode == 1 && it >= 4) {
#pragma unroll
      for (int i = 0; i < 16; ++i) {
        int d0 = qpos - (kbase + crow(i, h)); int d1 = d0 - 32;
        if (d0 > 128 || d0 < -128) s0[i] = -1e30f;
        if (d1 > 128 || d1 < -128) s1[i] = -1e30f;
      }
    }
    float mx = s0[0];
#pragma unroll
    for (int i = 1; i < 16; ++i) mx = fmaxf(mx, s0[i]);
#pragma unroll
    for (int i = 0; i < 16; ++i) mx = fmaxf(mx, s1[i]);
    mx = fmaxf(mx, __shfl_xor(mx, 32));
    const float mn = fmaxf(m, mx);
    const float alpha = __builtin_amdgcn_exp2f(m - mn);
    m = mn;
    float ps = 0.f;
#pragma unroll
    for (int i = 0; i < 16; ++i) { s0[i] = __builtin_amdgcn_exp2f(s0[i] - mn); ps += s0[i]; s1[i] = __builtin_amdgcn_exp2f(s1[i] - mn); ps += s1[i]; }
    lsum = lsum * alpha + ps;
#pragma unroll
    for (int i = 0; i < 16; ++i) { o0[i] *= alpha; o1[i] *= alpha; }
    b16x8 pf[4];
    {
      u32x4 v;
      v[0] = pk2(s0[0], s0[1]); v[1] = pk2(s0[2], s0[3]); v[2] = pk2(s0[4], s0[5]); v[3] = pk2(s0[6], s0[7]); pf[0] = __builtin_bit_cast(b16x8, v);
      v[0] = pk2(s0[8], s0[9]); v[1] = pk2(s0[10], s0[11]); v[2] = pk2(s0[12], s0[13]); v[3] = pk2(s0[14], s0[15]); pf[1] = __builtin_bit_cast(b16x8, v);
      v[0] = pk2(s1[0], s1[1]); v[1] = pk2(s1[2], s1[3]); v[2] = pk2(s1[4], s1[5]); v[3] = pk2(s1[6], s1[7]); pf[2] = __builtin_bit_cast(b16x8, v);
      v[0] = pk2(s1[8], s1[9]); v[1] = pk2(s1[10], s1[11]); v[2] = pk2(s1[12], s1[13]); v[3] = pk2(s1[14], s1[15]); pf[3] = __builtin_bit_cast(b16x8, v);
    }
#pragma unroll
    for (int ks = 0; ks < 4; ++ks) {
      const unsigned char* v0 = Vs + r * 144 + (16 * ks + 4 * h) * 2;
      const unsigned char* v1 = Vs + (32 + r) * 144 + (16 * ks + 4 * h) * 2;
      o0 = mfma(ldsfrag2(v0, v0 + 16), pf[ks], o0);
      o1 = mfma(ldsfrag2(v1, v1 + 16), pf[ks], o1);
    }
  };
  __syncthreads();
  gl(pk_, pv_, 0);
  if (ntl > 1) gl(qk_, qv_, 1);
  ls(pk_, pv_, 0);
  if (ntl > 2) gl(pk_, pv_, 2);
  __syncthreads();
  for (int it = 0; it < ntl; it += 2) {
    if (it + 1 < ntl) ls(qk_, qv_, 1);
    if (it + 3 < ntl) gl(qk_, qv_, it + 3);
    compute(0, it);
    __syncthreads();
    if (it + 1 < ntl) {
      if (it + 2 < ntl) ls(pk_, pv_, 0);
      if (it + 4 < ntl) gl(pk_, pv_, it + 4);
      compute(1, it + 1);
      __syncthreads();
    }
  }
  float lt = lsum + __shfl_xor(lsum, 32);
  if (has_sink) lt += __builtin_amdgcn_exp2f(sink * LOG2E - m);
  const float inv = 1.f / lt;
  us* Op = O + qrow * 512 + head * 64;
#pragma unroll
  for (int q = 0; q < 4; ++q) {
    u32x2 a, c2;
    a[0] = pk2(o0[4 * q] * inv, o0[4 * q + 1] * inv); a[1] = pk2(o0[4 * q + 2] * inv, o0[4 * q + 3] * inv);
    c2[0] = pk2(o1[4 * q] * inv, o1[4 * q + 1] * inv); c2[1] = pk2(o1[4 * q + 2] * inv, o1[4 * q + 3] * inv);
    *(u32x2*)(Op + 8 * q + 4 * h) = a;
    *(u32x2*)(Op + 32 + 8 * q + 4 * h) = c2;
  }
  __syncthreads();
}

constexpr int SSD_HALF = 62976;
DI void ssd_item(const Params& p, int l, int b, int hd, int seg, unsigned char* smem0) {
  const int tt = tidx(), dir = tt >> 8, t = tt & 255, lane = t & 63, w = t >> 6, r = lane & 31, h = lane >> 5;
  unsigned char* smem = smem0 + dir * SSD_HALF;
  const int g = hd >> 3, ib = w & 1, pb = w >> 1;
  const bool fwd = dir == 0;
  unsigned char* Cs = smem;
  unsigned char* Bs = smem + 17408;
  unsigned char* Hs = smem + 34816;
  unsigned char* Xs = smem + 52224;
  float* dtv = (float*)(smem + 61440);
  float* acs = dtv + 64;
  const float a_coef = -expf(p.ssm_A_log[l * 32 + dir * 16 + hd]);
  const float Dsk = p.ssm_D[l * 16 + hd];
  const us* CN = (const us*)(p.ws + OFF_CN) + (size_t)b * POS * 256 + g * 128;
  const us* BN = (const us*)(p.ws + OFF_BN) + (size_t)b * POS * 256 + g * 128;
  const us* BT = (const us*)(p.ws + OFF_BT) + ((size_t)(b * 256 + g * 128 + w * 32 + r)) * POS;
  const us* XT = (const us*)(p.ws + OFF_XT) + ((size_t)(b * 1024 + hd * 64)) * POS;
  const float* DT = (const float*)(p.ws + OFF_DT) + (size_t)b * POS * 32 + dir * 16 + hd;
  us* Y = (us*)(p.ws + (fwd ? OFF_YF : OFF_YB)) + (size_t)b * POS * 1024 + hd * 64;
  f32x16 hT0 = fzero(), hT1 = fzero();
  u32x4 nc[4], nbv[4], nx[2]; float ndt = 0.f;
  auto chunk_of = [&](int ci) { return fwd ? ci : (ci < 4 ? 3 - ci : 71 - ci); };
  auto prefetch = [&](int ci) {
    const int p0 = chunk_of(ci) * 64;
#pragma unroll
    for (int i = 0; i < 4; ++i) {
      int c = t + 256 * i, rw = c >> 4, chn = c & 15;
      nc[i] = *(const u32x4*)(CN + (size_t)(p0 + rw) * 256 + chn * 8);
      nbv[i] = *(const u32x4*)(BN + (size_t)(p0 + rw) * 256 + chn * 8);
    }
#pragma unroll
    for (int i = 0; i < 2; ++i) {
      int c = t + 256 * i, rw = c >> 3, chn = c & 7;
      nx[i] = *(const u32x4*)(XT + (size_t)rw * POS + p0 + chn * 8);
    }
    if (w == 0) { const int ln_ = tidx() & 63; ndt = DT[(size_t)(p0 + ln_) * 32]; }
  };
  const int ci0 = seg * 34, ci1 = ci0 + 34;
  __syncthreads();
  if (t == 0) acs[64] = 0.f;
  prefetch(ci0);
  for (int ci = ci0; ci < ci1; ++ci) {
    const int chunk = chunk_of(ci);
    const int pos0 = chunk * 64;
#pragma unroll
    for (int i = 0; i < 4; ++i) {
      int c = t + 256 * i, rw = c >> 4, chn = c & 15;
      *(u32x4*)(Cs + rw * 272 + chn * 16) = nc[i];
      *(u32x4*)(Bs + rw * 272 + chn * 16) = nbv[i];
    }
#pragma unroll
    for (int i = 0; i < 2; ++i) {
      int c = t + 256 * i, rw = c >> 3, chn = c & 7;
      *(u32x4*)(Xs + rw * 144 + chn * 16) = nx[i];
    }
    if (w == 0) {
      float d = ndt;
      float a = d * a_coef;
      if (fwd) {
#pragma unroll
        for (int o = 1; o < 64; o <<= 1) { float n = __shfl_up(a, o); if (lane >= o) a += n; }
      } else {
#pragma unroll
        for (int o = 1; o < 64; o <<= 1) { float n = __shfl_down(a, o); if (lane + o < 64) a += n; }
      }
      dtv[lane] = d; acs[lane] = a;
      acs[72 + lane] = d * __expf(__shfl(a, fwd ? 63 : 0) - a);
      if (seg == 1) {
        const float tot_ = __shfl(a, fwd ? 63 : 0);
        if (lane == 0) { const int d_ = tidx() >> 8; const float cum = acs[64]; ((float*)(p.ws + OFF_CUMP))[((b * 2 + d_) * 16 + hd) * 34 + (ci - 34)] = cum; acs[64] = cum + tot_; }
      }
    }
#pragma unroll
    for (int q = 0; q < 4; ++q) {
      u32x2 a, c2;
      a[0] = pk2(hT0[4 * q], hT0[4 * q + 1]); a[1] = pk2(hT0[4 * q + 2], hT0[4 * q + 3]);
      c2[0] = pk2(hT1[4 * q], hT1[4 * q + 1]); c2[1] = pk2(hT1[4 * q + 2], hT1[4 * q + 3]);
      *(u32x2*)(Hs + r * 272 + (w * 32 + 8 * q + 4 * h) * 2) = a;
      *(u32x2*)(Hs + (32 + r) * 272 + (w * 32 + 8 * q + 4 * h) * 2) = c2;
    }
    __syncthreads();
    if (ci + 1 < ci1) prefetch(ci + 1);
    const int iloc = ib * 32 + r;
    const float acs_i = acs[iloc];
    f32x16 yo;
    {
      f32x16 y0 = fzero(), y1 = fzero();
#pragma unroll
      for (int s4 = 0; s4 < 8; s4 += 4) {
        b16x8 hf[4], cf[4];
#pragma unroll
        for (int s = 0; s < 4; ++s) { hf[s] = ldsfrag(Hs + (pb * 32 + r) * 272 + (16 * (s4 + s) + 8 * h) * 2); cf[s] = ldsfrag(Cs + iloc * 272 + (16 * (s4 + s) + 8 * h) * 2); }
        y0 = mfma(hf[0], cf[0], y0); y1 = mfma(hf[1], cf[1], y1); y0 = mfma(hf[2], cf[2], y0); y1 = mfma(hf[3], cf[3], y1);
      }
#pragma unroll
      for (int i = 0; i < 16; ++i) yo[i] = y0[i] + y1[i];
    }
    b16x8 wf[4];
#pragma unroll
    for (int jb = 0; jb < 2; ++jb) {
      const bool act = fwd ? (jb <= ib) : (jb >= ib);
      u32x4 f0, f1;
      f0[0] = 0; f0[1] = 0; f0[2] = 0; f0[3] = 0; f1 = f0;
      if (act) {
        f32x16 g0 = fzero(), g1 = fzero();
#pragma unroll
        for (int s4 = 0; s4 < 8; s4 += 4) {
          b16x8 bfg[4], cf[4];
#pragma unroll
          for (int s = 0; s < 4; ++s) { bfg[s] = ldsfrag(Bs + (jb * 32 + r) * 272 + (16 * (s4 + s) + 8 * h) * 2); cf[s] = ldsfrag(Cs + iloc * 272 + (16 * (s4 + s) + 8 * h) * 2); }
          g0 = mfma(bfg[0], cf[0], g0); g1 = mfma(bfg[1], cf[1], g1); g0 = mfma(bfg[2], cf[2], g0); g1 = mfma(bfg[3], cf[3], g1);
        }
        float wv[16];
#pragma unroll
        for (int q4 = 0; q4 < 4; ++q4) {
          const int j0 = jb * 32 + 8 * q4 + 4 * h;
          const f32x4 aj = *(const f32x4*)(acs + j0), dj = *(const f32x4*)(dtv + j0);
#pragma unroll
          for (int e4 = 0; e4 < 4; ++e4) {
            const int i = 4 * q4 + e4, j = j0 + e4;
            bool valid = fwd ? (j <= iloc) : (j >= iloc);
            float e = valid ? __expf(acs_i - aj[e4]) * dj[e4] : 0.f;
            wv[i] = (g0[i] + g1[i]) * e;
          }
        }
        f0[0] = pk2(wv[0], wv[1]); f0[1] = pk2(wv[2], wv[3]); f0[2] = pk2(wv[4], wv[5]); f0[3] = pk2(wv[6], wv[7]);
        f1[0] = pk2(wv[8], wv[9]); f1[1] = pk2(wv[10], wv[11]); f1[2] = pk2(wv[12], wv[13]); f1[3] = pk2(wv[14], wv[15]);
      }
      wf[jb * 2] = __builtin_bit_cast(b16x8, f0); wf[jb * 2 + 1] = __builtin_bit_cast(b16x8, f1);
    }
    u32x4 btf[4];
#pragma unroll
    for (int s = 0; s < 4; ++s) btf[s] = *(const u32x4*)(BT + pos0 + 16 * s + 8 * h);
    f32x16 yd = fzero();
    {
      b16x8 xf[4];
#pragma unroll
      for (int ks = 0; ks < 4; ++ks) { const unsigned char* xp = Xs + (pb * 32 + r) * 144 + (16 * ks + 4 * h) * 2; xf[ks] = ldsfrag2(xp, xp + 16); }
#pragma unroll
      for (int ks = 0; ks < 4; ++ks) yd = mfma(xf[ks], wf[ks], yd);
    }
    {
      const float ei = __expf(acs_i);
      us* yp = Y + (size_t)(pos0 + iloc) * 1024 + pb * 32;
#pragma unroll
      for (int q = 0; q < 4; ++q) {
        float v[4];
#pragma unroll
        for (int e = 0; e < 4; ++e) {
          int i = 4 * q + e;
          float val = yd[i] + ei * yo[i];
          if (fwd) val += Dsk * bf2f(*(const us*)(Xs + (pb * 32 + crow(i, h)) * 144 + iloc * 2));
          v[e] = val;
        }
        u32x2 o; o[0] = pk2(v[0], v[1]); o[1] = pk2(v[2], v[3]);
        *(u32x2*)(yp + 8 * q + 4 * h) = o;
      }
    }
    {
      const float tot = fwd ? acs[63] : acs[0];
      const float dec = __expf(tot);
#pragma unroll
      for (int i = 0; i < 16; ++i) { hT0[i] *= dec; hT1[i] *= dec; }
#pragma unroll
      for (int s = 0; s < 4; ++s) {
        u32x4 xv[1][2];
#pragma unroll
        for (int pbb = 0; pbb < 2; ++pbb) xv[0][pbb] = *(const u32x4*)(Xs + (pbb * 32 + r) * 144 + (16 * s + 8 * h) * 2);
        float wj[8];
        { const f32x4 w0 = *(const f32x4*)(acs + 72 + 16 * s + 8 * h), w1 = *(const f32x4*)(acs + 72 + 16 * s + 8 * h + 4);
          wj[0] = w0[0]; wj[1] = w0[1]; wj[2] = w0[2]; wj[3] = w0[3]; wj[4] = w1[0]; wj[5] = w1[1]; wj[6] = w1[2]; wj[7] = w1[3]; }
        b16x8 af = __builtin_bit_cast(b16x8, btf[s]);
#pragma unroll
        for (int pbb = 0; pbb < 2; ++pbb) {
          const u32x4 x4 = xv[0][pbb];
          u32x4 sv;
          sv[0] = pk2(bflo(x4[0]) * wj[0], bfhi(x4[0]) * wj[1]); sv[1] = pk2(bflo(x4[1]) * wj[2], bfhi(x4[1]) * wj[3]);
          sv[2] = pk2(bflo(x4[2]) * wj[4], bfhi(x4[2]) * wj[5]); sv[3] = pk2(bflo(x4[3]) * wj[6], bfhi(x4[3]) * wj[7]);
          if (pbb == 0) hT0 = mfma(af, __builtin_bit_cast(b16x8, sv), hT0);
          else hT1 = mfma(af, __builtin_bit_cast(b16x8, sv), hT1);
        }
      }
    }
    __syncthreads();
  }
  if (seg == 0) {
    const int t3 = tidx(), d3 = t3 >> 8, w3 = (t3 >> 6) & 3, r3 = t3 & 31, h3 = (t3 >> 5) & 1;
    us* HM = (us*)(p.ws + OFF_HMID) + (size_t)((b * 2 + d3) * 16 + hd) * 8192;
#pragma unroll
    for (int q = 0; q < 4; ++q) {
      u32x2 a, c2;
      a[0] = pk2(hT0[4 * q], hT0[4 * q + 1]); a[1] = pk2(hT0[4 * q + 2], hT0[4 * q + 3]);
      c2[0] = pk2(hT1[4 * q], hT1[4 * q + 1]); c2[1] = pk2(hT1[4 * q + 2], hT1[4 * q + 3]);
      *(u32x2*)(HM + r3 * 128 + w3 * 32 + 8 * q + 4 * h3) = a;
      *(u32x2*)(HM + (32 + r3) * 128 + w3 * 32 + 8 * q + 4 * h3) = c2;
    }
  }
}

DI void ssd_fix_item(const Params& p, int l, int it) {
  const int tt = tidx(), hh = tt >> 8, t = tt & 255, lane = t & 63, w = t >> 6, r = lane & 31, h = lane >> 5;
  const int sidx = it / 17, pair = it - sidx * 17;
  const int b = sidx >> 5, dir = (sidx >> 4) & 1, hd = sidx & 15, g = hd >> 3, ib = w & 1, pb = w >> 1;
  const bool fwd = dir == 0;
  const int cl = pair * 2 + hh, ci = 34 + cl;
  const int chunk = fwd ? ci : 71 - ci, pos0 = chunk * 64;
  const float a_coef = -expf(p.ssm_A_log[l * 32 + dir * 16 + hd]);
  float a = ((const float*)(p.ws + OFF_DT))[((size_t)b * POS + pos0 + lane) * 32 + dir * 16 + hd] * a_coef;
  if (fwd) {
#pragma unroll
    for (int o = 1; o < 64; o <<= 1) { float n = __shfl_up(a, o); if (lane >= o) a += n; }
  } else {
#pragma unroll
    for (int o = 1; o < 64; o <<= 1) { float n = __shfl_down(a, o); if (lane + o < 64) a += n; }
  }
  const int iloc = ib * 32 + r;
  const float acs_i = __shfl(a, iloc);
  const float e = __expf(((const float*)(p.ws + OFF_CUMP))[sidx * 34 + cl] + acs_i);
  const us* HM = (const us*)(p.ws + OFF_HMID) + (size_t)sidx * 8192 + (pb * 32 + r) * 128 + 8 * h;
  const us* CNp = (const us*)(p.ws + OFF_CN) + ((size_t)b * POS + pos0 + iloc) * 256 + g * 128 + 8 * h;
  f32x16 y0 = fzero(), y1 = fzero();
#pragma unroll
  for (int s4 = 0; s4 < 8; s4 += 4) {
    u32x4 hf[4], cf[4];
#pragma unroll
    for (int s = 0; s < 4; ++s) { hf[s] = *(const u32x4*)(HM + 16 * (s4 + s)); cf[s] = *(const u32x4*)(CNp + 16 * (s4 + s)); }
    y0 = mfma(__builtin_bit_cast(b16x8, hf[0]), __builtin_bit_cast(b16x8, cf[0]), y0); y1 = mfma(__builtin_bit_cast(b16x8, hf[1]), __builtin_bit_cast(b16x8, cf[1]), y1);
    y0 = mfma(__builtin_bit_cast(b16x8, hf[2]), __builtin_bit_cast(b16x8, cf[2]), y0); y1 = mfma(__builtin_bit_cast(b16x8, hf[3]), __builtin_bit_cast(b16x8, cf[3]), y1);
  }
  us* yp = (us*)(p.ws + (fwd ? OFF_YF : OFF_YB)) + ((size_t)b * POS + pos0 + iloc) * 1024 + hd * 64 + pb * 32;
#pragma unroll
  for (int q = 0; q < 4; ++q) {
    u32x2 o = *(const u32x2*)(yp + 8 * q + 4 * h);
    float v0 = bflo(o[0]) + e * (y0[4 * q] + y1[4 * q]), v1 = bfhi(o[0]) + e * (y0[4 * q + 1] + y1[4 * q + 1]);
    float v2 = bflo(o[1]) + e * (y0[4 * q + 2] + y1[4 * q + 2]), v3 = bfhi(o[1]) + e * (y0[4 * q + 3] + y1[4 * q + 3]);
    o[0] = pk2(v0, v1); o[1] = pk2(v2, v3);
    *(u32x2*)(yp + 8 * q + 4 * h) = o;
  }
}

template <int MB>
DI void zgate_tile(const Params& p, int l, int row0, int nt, unsigned char* smem) {
  const us* H = (const us*)(p.ws + OFF_H);
  const us* Wt = (const us*)p.ws + W_WIN + (size_t)(3200 + nt * 128) * 1024;
  if constexpr (MB == 4) {
    f32x4 acc[8][2];
    gemm_tile16<1>(acc, H + (size_t)row0 * 1024, 1024, 0, 256, Wt, 1024, 1024, smem);
    acc_to_lds16<1>(acc, 0, smem);
  } else {
    f32x16 acc[MB][1];
    gemm_tile<1, MB>(acc, H + (size_t)row0 * 1024, 1024, 0, 64 * MB, Wt, 1024, 1024, smem);
    acc_to_lds<1, MB>(acc, 0, smem);
  }
  __syncthreads();
  const int t = tidx(), cg8 = t & 15;
  us* YF = (us*)(p.ws + OFF_YF); const us* YB = (const us*)(p.ws + OFF_YB);
  float* PART = (float*)(p.ws + OFF_PART);
  float gn[8];
#pragma unroll
  for (int q = 0; q < 8; ++q) gn[q] = p.ssm_norm[l * 1024 + nt * 128 + cg8 * 8 + q];
  u32x4 yfr[2 * MB], ybr[2 * MB];
#pragma unroll
  for (int itr = 0; itr < 2 * MB; ++itr) {
    size_t off = (size_t)(row0 + (t >> 4) + 32 * itr) * 1024 + nt * 128 + cg8 * 8;
    yfr[itr] = *(const u32x4*)(YF + off); ybr[itr] = *(const u32x4*)(YB + off);
  }
#pragma unroll
  for (int itr = 0; itr < 2 * MB; ++itr) {
    int rr = (t >> 4) + 32 * itr; float z[8], yf[8], yb[8], o[8];
    lds_row8(smem, rr, cg8, z);
    size_t off = (size_t)(row0 + rr) * 1024 + nt * 128 + cg8 * 8;
    { const u32x4 a = yfr[itr], b2 = ybr[itr];
      yf[0] = bflo(a[0]); yf[1] = bfhi(a[0]); yf[2] = bflo(a[1]); yf[3] = bfhi(a[1]); yf[4] = bflo(a[2]); yf[5] = bfhi(a[2]); yf[6] = bflo(a[3]); yf[7] = bfhi(a[3]);
      yb[0] = bflo(b2[0]); yb[1] = bfhi(b2[0]); yb[2] = bflo(b2[1]); yb[3] = bfhi(b2[1]); yb[4] = bflo(b2[2]); yb[5] = bfhi(b2[2]); yb[6] = bflo(b2[3]); yb[7] = bfhi(b2[3]); }
    float ss = 0.f;
#pragma unroll
    for (int q = 0; q < 8; ++q) { float v = (yf[q] + yb[q]) * silu(z[q]); ss += v * v; o[q] = v * gn[q]; }
    store8bf(YF + off, o);
    ss += __shfl_xor(ss, 1); ss += __shfl_xor(ss, 2); ss += __shfl_xor(ss, 4); ss += __shfl_xor(ss, 8);
    if (cg8 == 0) PART[(size_t)(row0 + rr) * 8 + nt] = ss;
  }
  __syncthreads();
}

template <int MB>
DI void merge_tile(const Params& p, int l, int row0, int nt, unsigned char* smem) {
  const int t = tidx(), lane = t & 63, w = t >> 6, h = lane >> 5, wm = w >> 2;
  float* rs = (float*)(smem + LDS_MAIN);
  if (t < 64 * MB) {
    const float* pp = (const float*)(p.ws + OFF_PART) + (size_t)(row0 + t) * 8;
    float s = ((pp[0] + pp[1]) + (pp[2] + pp[3])) + ((pp[4] + pp[5]) + (pp[6] + pp[7]));
    rs[t] = rsqrtf(s * (1.f / 1024.f) + EPS);
  }
  const us* H = (const us*)(p.ws + OFF_H) + (size_t)row0 * 1024;
  const us* Wb = (const us*)p.ws;
  us* M = (us*)(p.ws + OFF_M);
#pragma unroll 1
  for (int br = 0; br < 3; ++br) {
    { int z_ = 0; asm volatile("" : "+v"(z_)); row0 += z_; }
    const us* Ya; const us* Wo; int K;
    if (br == 0) { Ya = (const us*)(p.ws + OFF_YA) + (size_t)row0 * 512; Wo = Wb + W_WOA + (size_t)nt * 128 * 512; K = 512; }
    else if (br == 1) { Ya = (const us*)(p.ws + OFF_YF) + (size_t)row0 * 1024; Wo = Wb + W_WOB + (size_t)nt * 128 * 1024; K = 1024; }
    else { Ya = (const us*)(p.ws + OFF_YC) + (size_t)row0 * 512; Wo = Wb + W_WOC + (size_t)nt * 128 * 512; K = 512; }
    if constexpr (MB == 4) {
      unsigned gp[8][2][2];
      {
        f32x4 acc[8][2];
        gemm_tile16<1>(acc, H, 1024, 0, 256, Wb + W_WIN + (size_t)(4224 + br * 1024 + nt * 128) * 1024, 1024, 1024, smem);
#pragma unroll
        for (int i = 0; i < 8; ++i)
#pragma unroll
          for (int j = 0; j < 2; ++j) { gp[i][j][0] = pk2(sigmoidf(acc[i][j][0]), sigmoidf(acc[i][j][1])); gp[i][j][1] = pk2(sigmoidf(acc[i][j][2]), sigmoidf(acc[i][j][3])); }
      }
      f32x4 acc[8][2];
      gemm_tile16<1>(acc, Ya, K, 0, 256, Wo, K, K, smem);
      const int quad = lane >> 4;
#pragma unroll
      for (int i = 0; i < 8; ++i) {
        f32x4 sc4; sc4[0] = 1.f; sc4[1] = 1.f; sc4[2] = 1.f; sc4[3] = 1.f;
        if (br == 1) sc4 = *(const f32x4*)(rs + wm * 128 + i * 16 + quad * 4);
#pragma unroll
        for (int j = 0; j < 2; ++j) {
          acc[i][j][0] *= bflo(gp[i][j][0]) * sc4[0]; acc[i][j][1] *= bfhi(gp[i][j][0]) * sc4[1];
          acc[i][j][2] *= bflo(gp[i][j][1]) * sc4[2]; acc[i][j][3] *= bfhi(gp[i][j][1]) * sc4[3];
        }
      }
      acc_to_lds16<1>(acc, 0, smem);
    } else {
      unsigned gp[MB][8];
      {
        f32x16 acc[MB][1];
        gemm_tile<1, MB>(acc, H, 1024, 0, 64 * MB, Wb + W_WIN + (size_t)(4224 + br * 1024 + nt * 128) * 1024, 1024, 1024, smem);
#pragma unroll
        for (int i = 0; i < MB; ++i)
#pragma unroll
          for (int q = 0; q < 8; ++q) gp[i][q] = pk2(sigmoidf(acc[i][0][2 * q]), sigmoidf(acc[i][0][2 * q + 1]));
      }
      f32x16 acc[MB][1];
      gemm_tile<1, MB>(acc, Ya, K, 0, 64 * MB, Wo, K, K, smem);
#pragma unroll
      for (int i = 0; i < MB; ++i)
#pragma unroll
        for (int q = 0; q < 16; ++q) {
          float gv = (q & 1) ? bfhi(gp[i][q >> 1]) : bflo(gp[i][q >> 1]);
          float sc = (br == 1) ? rs[wm * 32 * MB + i * 32 + crow(q, h)] : 1.f;
          acc[i][0][q] *= gv * sc;
        }
      acc_to_lds<1, MB>(acc, 0, smem);
    }
    __syncthreads();
    const int t2 = tidx(), cg8 = t2 & 15;
    u32x4 pm[2 * MB];
    if (br > 0) {
#pragma unroll
      for (int itr = 0; itr < 2 * MB; ++itr) pm[itr] = *(const u32x4*)(M + (size_t)(row0 + (t2 >> 4) + 32 * itr) * 1024 + nt * 128 + cg8 * 8);
    }
#pragma unroll
    for (int itr = 0; itr < 2 * MB; ++itr) {
      int rr = (t2 >> 4) + 32 * itr; float v[8];
      lds_row8(smem, rr, cg8, v);
      us* mp = M + (size_t)(row0 + rr) * 1024 + nt * 128 + cg8 * 8;
      if (br > 0) {
        const u32x4 a = pm[itr];
        v[0] += bflo(a[0]); v[1] += bfhi(a[0]); v[2] += bflo(a[1]); v[3] += bfhi(a[1]); v[4] += bflo(a[2]); v[5] += bfhi(a[2]); v[6] += bflo(a[3]); v[7] += bfhi(a[3]);
      }
      store8bf(mp, v);
    }
    __syncthreads();
  }
}

template <int MB>
DI void resid_tile(const Params& p, int l, int row0, int nt, const us* A, int K, const us* Wt, int gate_off, bool src_in, unsigned char* smem) {
  if constexpr (MB == 4) {
    f32x4 acc[8][2];
    gemm_tile16<1>(acc, A + (size_t)row0 * K, K, 0, 256, Wt + (size_t)nt * 128 * K, K, K, smem);
    acc_to_lds16<1>(acc, 0, smem);
  } else {
    f32x16 acc[MB][1];
    gemm_tile<1, MB>(acc, A + (size_t)row0 * K, K, 0, 64 * MB, Wt + (size_t)nt * 128 * K, K, K, smem);
    acc_to_lds<1, MB>(acc, 0, smem);
  }
  __syncthreads();
  const int t = tidx(), cg8 = t & 15;
  const float* cm = cmod_row(p, l, row0) + gate_off + nt * 128 + cg8 * 8;
  f32x4 g0 = *(const f32x4*)cm, g1 = *(const f32x4*)(cm + 4);
  f32x4 xr0[2 * MB], xr1[2 * MB];
#pragma unroll
  for (int itr = 0; itr < 2 * MB; ++itr) {
    const float* xs = xrow_r(p, src_in, row0 + (t >> 4) + 32 * itr) + nt * 128 + cg8 * 8;
    xr0[itr] = *(const f32x4*)xs; xr1[itr] = *(const f32x4*)(xs + 4);
  }
#pragma unroll
  for (int itr = 0; itr < 2 * MB; ++itr) {
    int rr = (t >> 4) + 32 * itr; float v[8];
    lds_row8(smem, rr, cg8, v);
    float* xd = xrow_w(p, row0 + rr) + nt * 128 + cg8 * 8;
    f32x4 x0 = xr0[itr], x1 = xr1[itr], o0, o1;
    o0[0] = x0[0] + g0[0] * v[0]; o0[1] = x0[1] + g0[1] * v[1]; o0[2] = x0[2] + g0[2] * v[2]; o0[3] = x0[3] + g0[3] * v[3];
    o1[0] = x1[0] + g1[0] * v[4]; o1[1] = x1[1] + g1[1] * v[5]; o1[2] = x1[2] + g1[2] * v[6]; o1[3] = x1[3] + g1[3] * v[7];
    *(f32x4*)xd = o0; *(f32x4*)(xd + 4) = o1;
  }
  __syncthreads();
}

DI void resid_tile_w(const Params& p, int l, int row0, int ntw, const us* A, int K, const us* Wt, int gate_off, bool src_in, unsigned char* smem) {
  f32x4 acc[8][4];
  gemm_tile16<2>(acc, A + (size_t)row0 * K, K, 0, 256, Wt + (size_t)ntw * 256 * K, K, K, smem);
#pragma unroll
  for (int half = 0; half < 2; ++half) {
    const int nt = ntw * 2 + half;
    acc_to_lds16<2>(acc, half, smem);
    __syncthreads();
    const int t = tidx(), cg8 = t & 15;
    const float* cm = cmod_row(p, l, row0) + gate_off + nt * 128 + cg8 * 8;
    f32x4 g0 = *(const f32x4*)cm, g1 = *(const f32x4*)(cm + 4);
    f32x4 xr0[8], xr1[8];
#pragma unroll
    for (int itr = 0; itr < 8; ++itr) {
      const float* xs = xrow_r(p, src_in, row0 + (t >> 4) + 32 * itr) + nt * 128 + cg8 * 8;
      xr0[itr] = *(const f32x4*)xs; xr1[itr] = *(const f32x4*)(xs + 4);
    }
#pragma unroll
    for (int itr = 0; itr < 8; ++itr) {
      int rr = (t >> 4) + 32 * itr; float v[8];
      lds_row8(smem, rr, cg8, v);
      float* xd = xrow_w(p, row0 + rr) + nt * 128 + cg8 * 8;
      f32x4 x0 = xr0[itr], x1 = xr1[itr], o0, o1;
      o0[0] = x0[0] + g0[0] * v[0]; o0[1] = x0[1] + g0[1] * v[1]; o0[2] = x0[2] + g0[2] * v[2]; o0[3] = x0[3] + g0[3] * v[3];
      o1[0] = x1[0] + g1[0] * v[4]; o1[1] = x1[1] + g1[1] * v[5]; o1[2] = x1[2] + g1[2] * v[6]; o1[3] = x1[3] + g1[3] * v[7];
      *(f32x4*)xd = o0; *(f32x4*)(xd + 4) = o1;
    }
    __syncthreads();
  }
}

DI void ffn1_tile(const Params& p, int l, int ftile, int nt2, unsigned char* smem) {
  const int b = ftile / 19, q = ftile - b * 19;
  int seg_lo, seg_hi, idx;
  if (q < 2) { seg_lo = 0; seg_hi = LC; idx = q; } else { seg_lo = LC; seg_hi = POS; idx = q - 2; }
  const int s = seg_lo + idx * 254;
  int r_lo = (s - 1 < seg_lo) ? 1 : 0;
  int r_hi = seg_hi - (s - 1); if (r_hi > 256) r_hi = 256;
  const us* A = (const us*)(p.ws + OFF_H2) + ((long)b * POS + s - 1) * 1024;
  const us* Wt = (const us*)p.ws + W_WUG + (size_t)nt2 * 256 * 1024;
  f32x4 acc[8][4];
  gemm_tile16<2>(acc, A, 1024, r_lo, r_hi, Wt, 1024, 1024, smem);
  const float* Cs = (const float*)smem;
#pragma unroll
  for (int half = 0; half < 2; ++half) {
    acc_to_lds16<2>(acc, half, smem);
    __syncthreads();
    const int t = tidx(), cg = t & 7, rb = t >> 3;
    const int c = (nt2 * 2 + half) * 64 + cg * 8;
    float w0[8], w1[8], w2[8], bias[8];
#pragma unroll
    for (int q = 0; q < 8; ++q) {
      w0[q] = p.ffn_conv_w[(l * 3 + 0) * DFF + c + q]; w1[q] = p.ffn_conv_w[(l * 3 + 1) * DFF + c + q];
      w2[q] = p.ffn_conv_w[(l * 3 + 2) * DFF + c + q]; bias[q] = p.ffn_conv_b[l * DFF + c + q];
    }
    us* ACT = (us*)(p.ws + OFF_ACT) + ((size_t)b * POS) * DFF + c;
#pragma unroll
    for (int itr = 0; itr < 4; ++itr) {
      const int rr = 1 + rb + 64 * itr;
      const int pos = s - 1 + rr;
      if (rr <= 254 && pos < seg_hi) {
        float gm[8], g0[8], gp[8], up[8], o[8];
        lds_row8(smem, rr - 1, cg, gm); lds_row8(smem, rr, cg, g0); lds_row8(smem, rr + 1, cg, gp); lds_row8(smem, rr, 8 + cg, up);
        const bool hasm = pos - 1 >= seg_lo, hasp = pos + 1 < seg_hi;
#pragma unroll
        for (int q = 0; q < 8; ++q) o[q] = silu(bias[q] + (hasm ? w0[q] * gm[q] : 0.f) + w1[q] * g0[q] + (hasp ? w2[q] * gp[q] : 0.f)) * up[q];
        store8bf(ACT + (size_t)pos * DFF, o);
      }
    }
    __syncthreads();
  }
}

DI void final_item(const Params& p, int it) {
  const int lane = tidx() & 63, w = tidx() >> 6;
  const int row = it * 8 + w;
  float* xr = p.out + (size_t)row * DM;
  f32x4 v[4]; float ss = 0.f;
#pragma unroll
  for (int i = 0; i < 4; ++i) { v[i] = *(const f32x4*)(xr + i * 256 + lane * 4); ss += v[i][0] * v[i][0] + v[i][1] * v[i][1] + v[i][2] * v[i][2] + v[i][3] * v[i][3]; }
#pragma unroll
  for (int o = 32; o > 0; o >>= 1) ss += __shfl_xor(ss, o);
  const float rstd = rsqrtf(ss * (1.f / DM) + EPS);
#pragma unroll
  for (int i = 0; i < 4; ++i) {
    f32x4 gg = *(const f32x4*)(p.final_norm + i * 256 + lane * 4), o;
    o[0] = v[i][0] * rstd * gg[0]; o[1] = v[i][1] * rstd * gg[1]; o[2] = v[i][2] * rstd * gg[2]; o[3] = v[i][3] * rstd * gg[3];
    *(f32x4*)(xr + i * 256 + lane * 4) = o;
  }
}

DI void mixer_item(const Params& p, int l, int it, unsigned char* smem) {
  if (it < 128) { ssd_item(p, l, it >> 5, (it >> 1) & 15, it & 1, smem); return; }
  it -= 128;
  const us* QA = (const us*)(p.ws + OFF_QA); const us* QC = (const us*)(p.ws + OFF_QC);
  const us* KA = (const us*)(p.ws + OFF_KA); const us* KC = (const us*)(p.ws + OFF_KC);
  const us* VAT = (const us*)(p.ws + OFF_VAT); const us* VCT = (const us*)(p.ws + OFF_VCT);
  us* YA = (us*)(p.ws + OFF_YA); us* YC = (us*)(p.ws + OFF_YC);
  if (it < 512) { int qb = it & 15, head = (it >> 4) & 7, b = it >> 7; attn_item(QC, KC, VCT, YC, b, head, LC + qb * 256, 0, 68, false, 0.f, smem); return; }
  it -= 512;
  if (it < 512) { int qb = it & 15, head = (it >> 4) & 7, b = it >> 7; attn_item(QA, KA, VAT, YA, b, head, LC + qb * 256, 1, 0, true, p.a_sink[l * 8 + head], smem); return; }
  it -= 512;
  if (it < 32) { int head = it & 7, b = it >> 3; attn_item(QC, KC, VCT, YC, b, head, 0, 0, 4, false, 0.f, smem); return; }
  it -= 32;
  { int head = it & 7, b = it >> 3; attn_item(QA, KA, VAT, YA, b, head, 0, 0, 4, true, p.a_sink[l * 8 + head], smem); }
}

#define XB_TMO      128
#define XB_XCNT(j)  (256  + 64 * (j))
#define XB_XSUB(j)  (1280 + 64 * (j))
#define XB_XGEN(j)  (2304 + 64 * (j))
#define XB_TOP      3328
#define XB_TOPGEN   3392
#define XCD_BAR_WORDS 3456
#define XB_SPIN_CAP (1u << 20)
DI unsigned xb_ld(unsigned* p) { return __hip_atomic_load(p, __ATOMIC_RELAXED, __HIP_MEMORY_SCOPE_AGENT); }
DI unsigned xb_add(unsigned* p, unsigned v) { return __hip_atomic_fetch_add(p, v, __ATOMIC_RELAXED, __HIP_MEMORY_SCOPE_AGENT); }
DI unsigned xb_xcc_id() { return (unsigned)__builtin_amdgcn_s_getreg((3 << 11) | 20) & 0xFu; }
#define XB_SPIN(cond, bar) do { unsigned _sp = 0; while (cond) { __builtin_amdgcn_s_sleep(1); \
    if ((++_sp & 255u) == 0u) { if (xb_ld(&(bar)[XB_TMO])) break; if (_sp > XB_SPIN_CAP) { atomicAdd(&(bar)[XB_TMO], 1u); break; } } } } while (0)
struct XcdBarrier { unsigned* bar; unsigned x; unsigned rank; volatile LAS unsigned* st; };
DI XcdBarrier xcd_barrier_post(unsigned* bar, volatile LAS unsigned* st) {
  XcdBarrier b; b.bar = bar; b.x = xb_xcc_id(); b.st = st;
  b.rank = 0u;
  if (threadIdx.x == 0) b.rank = xb_add(&bar[XB_XCNT(b.x)], 1u);
  return b;
}
DI void xcd_barrier_complete(unsigned* bar, unsigned x, unsigned& nloc, unsigned& nx) {
  const unsigned G = gridDim.x * gridDim.y * gridDim.z;
  unsigned sum, cnt, mine, sp = 0u;
  for (;;) {
    sum = 0u; cnt = 0u; mine = 0u;
#pragma unroll
    for (unsigned j = 0; j < 16; ++j) { const unsigned c = xb_ld(&bar[XB_XCNT(j)]); sum += c; cnt += (c > 0u) ? 1u : 0u; mine = (j == x) ? c : mine; }
    if (sum == G) break;
    __builtin_amdgcn_s_sleep(1);
    if ((++sp & 255u) == 0u) { if (xb_ld(&bar[XB_TMO])) break; if (sp > XB_SPIN_CAP) { atomicAdd(&bar[XB_TMO], 1u); break; } }
  }
  nloc = mine > 0u ? mine : 1u; nx = cnt > 0u ? cnt : 1u;
}
DI void xcd_barrier(unsigned* bar_, volatile LAS unsigned* st_) {
  XcdBarrier b; b.bar = bar_; b.st = st_; b.x = xb_xcc_id(); b.rank = 0u;
  asm volatile("s_waitcnt vmcnt(0)" ::: "memory");
  __syncthreads();
  if (threadIdx.x == 0) {
    unsigned* bar = b.bar;
    __builtin_amdgcn_s_waitcnt(0);
    unsigned nloc = b.st[0], nx = b.st[1];
    if (nloc == 0u) { xcd_barrier_complete(bar, b.x, nloc, nx); b.st[0] = nloc; b.st[1] = nx; }
    const unsigned old = xb_add(&bar[XB_XSUB(b.x)], 1u);
    const unsigned gen = old / nloc;
    if (old + 1u == (gen + 1u) * nloc) {
      __builtin_amdgcn_fence(__ATOMIC_RELEASE, "agent");
      asm volatile("s_waitcnt vmcnt(0)" ::: "memory");
      const unsigned og = xb_add(&bar[XB_TOP], 1u);
      const unsigned tg = og / nx;
      if (og + 1u == (tg + 1u) * nx) xb_add(&bar[XB_TOPGEN], 1u);
      else XB_SPIN(xb_ld(&bar[XB_TOPGEN]) == tg, bar);
      __builtin_amdgcn_fence(__ATOMIC_ACQUIRE, "agent");
      xb_add(&bar[XB_XGEN(b.x)], 1u);
      asm volatile("s_waitcnt vmcnt(0)" ::: "memory");
    } else {
      XB_SPIN(xb_ld(&bar[XB_XGEN(b.x)]) == gen, bar);
      __builtin_amdgcn_fence(__ATOMIC_ACQUIRE, "agent");
      asm volatile("s_waitcnt vmcnt(0)" ::: "memory");
    }
  }
  __syncthreads();
}

#define GEMM_PHASE(MTn, NTn, BODY)                                                     \
  {                                                                                    \
    const int per_ = G >> 3, ntile_ = (MTn) * (NTn);                                   \
    for (int s_ = 0; s_ * G < ntile_; ++s_) {                                          \
      const int idx_ = s_ * G + vbs[1] * per_ + vbs[2];                                \
      if (idx_ < ntile_) { const int mt = idx_ / (NTn), nt = idx_ % (NTn); BODY }      \
    }                                                                                  \
  }
#define GEMM_PHASE_SK(MTn, NTn, NPB, NC, SKIP, BODY)                                   \
  {                                                                                    \
    const int per_ = G >> 3, mtn_ = (SKIP) ? (MTn) - NB * (NC) : (MTn), ntile_ = mtn_ * (NTn); \
    for (int s_ = 0; s_ * G < ntile_; ++s_) {                                          \
      const int idx_ = s_ * G + vbs[1] * per_ + vbs[2];                                \
      if (idx_ < ntile_) {                                                             \
        const int ml_ = idx_ / (NTn), nt = idx_ % (NTn);                               \
        const int mt = (SKIP) ? (ml_ / ((NPB) - (NC))) * (NPB) + (NC) + ml_ % ((NPB) - (NC)) : ml_; \
        BODY                                                                           \
      }                                                                                \
    }                                                                                  \
  }

__global__ void __launch_bounds__(512, 2) hybrid_fwd(Params p0) {
  extern __shared__ __attribute__((aligned(16))) unsigned char smem[];
  cg::grid_group grid = cg::this_grid();
  const int G = gridDim.x, bid = blockIdx.x;
  volatile LAS unsigned* xst = (volatile LAS unsigned*)(smem + LDS_MAIN + 1024);
  if (threadIdx.x == 0) { xst[0] = 0u; xst[1] = 0u; }
  __syncthreads();
  volatile int* vbs = (volatile int*)(smem + LDS_MAIN + 1280);
  {
    const XcdBarrier xb = xcd_barrier_post((unsigned*)(p0.ws + OFF_BAR), xst);
    if (threadIdx.x == 0) { vbs[1] = bid & 7; vbs[2] = bid >> 3; vbs[3] = (int)xb.x; vbs[4] = (int)xb.rank; }
  }
  for (int ph = p0.ph_lo; ph < p0.ph_hi; ++ph) {
    const Params& p = p0;
    if (ph == 0) {
      const int n0 = 192, n1 = n0 + 256, n2 = n1 + NCONV_EARLY;
      for (int it = bid; it < n2; it += G) {
        if (it < n0) cmod_item(p, it, smem);
        else if (it < n1) rope_item(p, it - n0);
        else convw_item(p, 0, it - n1, smem);
      }
    } else if (ph == 23) {
      for (int it = bid; it < NB * SEQL / 8; it += G) final_item(p, it);
    } else {
      const int l = (ph - 1) / 11, sp = (ph - 1) % 11;
      const bool skipctx = (l == 1);
      const int nrep = ((TW >> sp) & 1) ? 2 : 1;
      for (int rep = 0; rep < nrep; ++rep) {
      if (rep) xcd_barrier((unsigned*)(p0.ws + OFF_BAR), xst);
      switch (sp) {
        case 0: {
          const int n0 = R / 8, n1 = n0;
          for (int it = bid; it < n1; it += G) {
            if (it < n0) normmod_item(p, l, 0, l == 0, (us*)(p.ws + OFF_H), it);
            else convw_item(p, 1, it - n0, smem);
          }
        } break;
        case 1:
          GEMM_PHASE(MT, 13, if (skipctx && (mt % 17) == 0 && (nt < 2 || nt == 3 || nt == 4)) {   } else if (nt < 12) inproj_tile(p, l, mt, nt, smem); else inproj_tile_dt(p, l, mt, smem);)
          {
            unsigned* cq = (unsigned*)(p.ws + OFF_CTL) + 8 + l;
            int* bc = (int*)(smem + LDS_MAIN + 1152);
            while (true) {
              __syncthreads();
              if (threadIdx.x == 0) *bc = (int)atomicAdd(cq, 1u);
              __syncthreads();
              const int it = *bc;
              if (it >= NCONV_ITEMS - NCONV_EARLY) break;
              convw_item(p, l, NCONV_EARLY + it, smem);
            }
          }
          break;
        case 2:
          for (int it = bid; it < NB * 34 * 24; it += G) conv_item(p, l, it, smem);
          break;
        case 3: {
          const int nitems = 128 + 1024 + (l == 0 ? 64 : 0);
          unsigned* ctr = (unsigned*)(p.ws + OFF_CTL) + l + 2 * rep;
          int* bc = (int*)(smem + LDS_MAIN + 1152);
          while (true) {
            __syncthreads();
            if (threadIdx.x == 0) *bc = (int)atomicAdd(ctr, 1u);
            __syncthreads();
            const int it = *bc;
            if (it >= nitems) break;
            mixer_item(p, l, it, smem);
          }
        } break;
        case 4:
          for (int it = bid; it < 128 * 17; it += G) ssd_fix_item(p, l, it);
          break;
        case 5:
          GEMM_PHASE_SK(MT, 8, 17, 1, true, zgate_tile<4>(p, l, mt * 256, nt, smem);)
          if (!skipctx) GEMM_PHASE(8, 8, zgate_tile<2>(p, l, (mt >> 1) * POS + (mt & 1) * 128, nt, smem);)
          break;
        case 6:
          GEMM_PHASE_SK(MT, 8, 17, 1, true, merge_tile<4>(p, l, mt * 256, nt, smem);)
          if (!skipctx) GEMM_PHASE(8, 8, merge_tile<2>(p, l, (mt >> 1) * POS + (mt & 1) * 128, nt, smem);)
          break;
        case 7:
          GEMM_PHASE_SK(MT, 4, 17, 1, true, resid_tile_w(p, l, mt * 256, nt, (const us*)(p.ws + OFF_M), 1024, (const us*)p.ws + W_WOUT, 2 * DM, l == 0, smem);)
          if (!skipctx) GEMM_PHASE(8, 8, resid_tile<2>(p, l, (mt >> 1) * POS + (mt & 1) * 128, nt, (const us*)(p.ws + OFF_M), 1024, (const us*)p.ws + W_WOUT, 2 * DM, l == 0, smem);)
          break;
        case 8:
          for (int it = bid; it < R / 8; it += G) {
            if (skipctx && ((it * 8) % POS) < LC) continue;
            normmod_item(p, l, 1, false, (us*)(p.ws + OFF_H2), it);
          }
          break;
        case 9:
          GEMM_PHASE_SK(76, 22, 19, 2, skipctx, ffn1_tile(p, l, mt, nt, smem);)
          break;
        case 10:
          GEMM_PHASE_SK(MT, 4, 17, 1, true, resid_tile_w(p, l, mt * 256, nt, (const us*)(p.ws + OFF_ACT), DFF, (const us*)p.ws + W_WDN, 5 * DM, false, smem);)
          if (!skipctx) GEMM_PHASE(8, 8, resid_tile<2>(p, l, (mt >> 1) * POS + (mt & 1) * 128, nt, (const us*)(p.ws + OFF_ACT), DFF, (const us*)p.ws + W_WDN, 5 * DM, false, smem);)
          if (l == 0) {
            unsigned* cq = (unsigned*)(p.ws + OFF_CTL) + 12;
            int* bc = (int*)(smem + LDS_MAIN + 1152);
            while (true) {
              __syncthreads();
              if (threadIdx.x == 0) *bc = (int)atomicAdd(cq, 1u);
              __syncthreads();
              const int it = *bc;
              if (it >= NCONV_EARLY) break;
              convw_item(p, 1, it, smem);
            }
          }
          break;
      }
      }
    }
    if (ph + 1 < p0.ph_hi) {
      if (ph == 0) {
        grid.sync();
        if (threadIdx.x == 0) {
          unsigned* bar = (unsigned*)(p0.ws + OFF_BAR);
          bool ok = (G & 7) == 0;
          for (unsigned j = 0; j < 16; ++j) { const unsigned c = xb_ld(&bar[XB_XCNT(j)]); if (j < 8 ? c != (unsigned)(G >> 3) : c != 0u) ok = false; }
          if (ok) { vbs[1] = vbs[3]; vbs[2] = vbs[4]; }
        }
        __syncthreads();
      }
      else xcd_barrier((unsigned*)(p0.ws + OFF_BAR), xst);
    }
  }
}

extern "C" void kernel_launch(void* const* d_in, const int* in_sizes, int n_in, void* d_out, int out_size, void* d_ws, size_t ws_size,
                              hipStream_t stream) {
  static int grid_blocks = 0;
  if (grid_blocks == 0) {
    if (ws_size < WS_NEED || n_in != 28) { fprintf(stderr, "kernel_launch: ws %zu < %zu or n_in %d\n", ws_size, (size_t)WS_NEED, n_in); grid_blocks = -1; return; }
    int dev = 0, cus = 0, per_cu = 0;
    (void)hipGetDevice(&dev);
    (void)hipDeviceGetAttribute(&cus, hipDeviceAttributeMultiprocessorCount, dev);
    (void)hipFuncSetAttribute((const void*)hybrid_fwd, hipFuncAttributeMaxDynamicSharedMemorySize, LDS_BYTES);
    (void)hipOccupancyMaxActiveBlocksPerMultiprocessor(&per_cu, (const void*)hybrid_fwd, NTHR, LDS_BYTES);
    if (per_cu < 1) { fprintf(stderr, "kernel_launch: occupancy query %d\n", per_cu); grid_blocks = -1; return; }
    grid_blocks = cus;
  }
  if (grid_blocks < 0) return;
  (void)hipMemsetAsync((unsigned char*)d_ws + OFF_CTL, 0, 256 + 3456 * 4, stream);
  Params p{};
  const float** pp = (const float**)&p;
  for (int i = 0; i < 28; ++i) pp[i] = (const float*)d_in[i];
  p.out = (float*)d_out; p.ws = (unsigned char*)d_ws; p.ph_lo = 0; p.ph_hi = 24;
  void* args[] = {&p};
  hipError_t e = hipLaunchCooperativeKernel((const void*)hybrid_fwd, dim3(grid_blocks), dim3(NTHR), args, LDS_BYTES, stream);
  if (e != hipSuccess) fprintf(stderr, "cooperative launch failed: %s (grid %d)\n", hipGetErrorString(e), grid_blocks);
}
```
